# Optimizing an MI355X kernel written in HIP

```python
import jax, jax.numpy as jnp
from jax import lax
import numpy as np

D_MODEL = 1024
BATCH = 16
SEQ = 2048
DEPTH = 4

N_MIXERS = 3
HEAD_DIM = 64
N_HEADS = D_MODEL // HEAD_DIM
MOBA_BLOCK = 256
MOBA_TOPK = 3
MOBA_QCHUNK = 64
SWA_WINDOW = 128
SWA_KV_HEADS = 4
SB_QBLOCK = 128
N_GROUPS = 4
EXPERTS_PER_GROUP = 8
N_EXPERTS = N_GROUPS * EXPERTS_PER_GROUP
TOPK_IN_GROUP = 2
D_EXPERT = 512
MOE_BLOCK = 256
PLE_DIM = 256
DEEPNORM_ALPHA = (2.0 * DEPTH) ** 0.25
DEEPNORM_BETA = (8.0 * DEPTH) ** -0.25
LN_EPS = 1e-5

kernel_name = 'hybrid_moba_swa_stickbreak_hmoe_deepnorm'


def _n_layers_of(mixer):
    return len(range(mixer, DEPTH, N_MIXERS))


def _alibi_slopes(n_heads):
    return jnp.asarray(np.array([2.0 ** (-8.0 * (h + 1) / n_heads) for h in range(n_heads)], dtype=np.float32))


def layer_norm(x, g, b):
    xf = x.astype(jnp.float32)
    mu = xf.mean(-1, keepdims=True)
    var = jnp.square(xf - mu).mean(-1, keepdims=True)
    y = (xf - mu) * lax.rsqrt(var + LN_EPS) * g.astype(jnp.float32) + b.astype(jnp.float32)
    return y.astype(x.dtype)


def moba_attention(q, k, v):
    bsz, seq, n_h, hd = q.shape
    s_pad = -(-seq // MOBA_BLOCK) * MOBA_BLOCK
    padw = ((0, 0), (0, s_pad - seq), (0, 0), (0, 0))
    qh = jnp.pad(q, padw).transpose(0, 2, 1, 3)
    kb = jnp.pad(k, padw).transpose(0, 2, 1, 3).reshape(bsz, n_h, -1, MOBA_BLOCK, hd)
    vb = jnp.pad(v, padw).transpose(0, 2, 1, 3).reshape(bsz, n_h, -1, MOBA_BLOCK, hd)
    n_blk = s_pad // MOBA_BLOCK
    k_sel = min(MOBA_TOPK, n_blk)
    scale = hd ** -0.5
    slopes = _alibi_slopes(n_h)
    q_blk = jnp.arange(s_pad) // MOBA_BLOCK
    k_mean = kb.astype(jnp.float32).mean(axis=3)
    gate = jnp.einsum('bhqd,bhnd->bhqn', qh.astype(jnp.float32), k_mean)
    gate = jnp.where(jnp.arange(n_blk)[None, :] < q_blk[:, None], gate, -jnp.inf)
    _, sel = lax.top_k(gate, k_sel)
    sel_valid = sel < q_blk[None, None, :, None]
    n_chunk = s_pad // MOBA_QCHUNK
    h_idx = jnp.arange(n_h)[:, None, None]
    blk_off = jnp.arange(MOBA_BLOCK)

    def chunk(idx):
        b = idx // n_chunk
        q0 = (idx % n_chunk) * MOBA_QCHUNK
        own = q0 // MOBA_BLOCK
        qc = lax.dynamic_slice_in_dim(qh[b], q0, MOBA_QCHUNK, axis=1)
        sel_c = lax.dynamic_slice_in_dim(sel[b], q0, MOBA_QCHUNK, axis=1)
        val_c = lax.dynamic_slice_in_dim(sel_valid[b], q0, MOBA_QCHUNK, axis=1)
        t_pos = q0 + jnp.arange(MOBA_QCHUNK)
        k_own = kb[b, :, own]
        v_own = vb[b, :, own]
        d_own = t_pos[:, None] - (own * MOBA_BLOCK + blk_off)[None, :]
        l_own = jnp.einsum('hqd,hkd->hqk', qc, k_own, preferred_element_type=jnp.float32) * scale - slopes[:, None, None] * d_own
        l_own = jnp.where(d_own >= 0, l_own, -jnp.inf)
        k_g = kb[b, h_idx, sel_c]
        v_g = vb[b, h_idx, sel_c]
        d_sel = t_pos[None, :, None, None] - (sel_c[..., None] * MOBA_BLOCK + blk_off)
        l_sel = jnp.einsum('hqd,hqnkd->hqnk', qc, k_g, preferred_element_type=jnp.float32) * scale - slopes[:, None, None, None] * d_sel
        l_sel = jnp.where(val_c[..., None], l_sel, -jnp.inf)
        logits = jnp.concatenate([l_own, l_sel.reshape(n_h, MOBA_QCHUNK, k_sel * MOBA_BLOCK)], axis=-1)
        w = jax.nn.softmax(logits, axis=-1).astype(v.dtype)
        w_sel = w[..., MOBA_BLOCK:].reshape(n_h, MOBA_QCHUNK, k_sel, MOBA_BLOCK)
        return jnp.einsum('hqk,hkd->hqd', w[..., :MOBA_BLOCK], v_own) + jnp.einsum('hqnk,hqnkd->hqd', w_sel, v_g)

    out = lax.map(chunk, jnp.arange(bsz * n_chunk))
    out = out.reshape(bsz, n_chunk, n_h, MOBA_QCHUNK, hd).transpose(0, 1, 3, 2, 4).reshape(bsz, s_pad, n_h, hd)
    return out[:, :seq]


def swa_gqa_attention(q, k, v, sinks):
    bsz, seq, n_h, hd = q.shape
    n_kv = k.shape[2]
    grp = n_h // n_kv
    win = SWA_WINDOW
    n_b = seq // win
    qb = q.reshape(bsz, n_b, win, n_kv, grp, hd)
    kb = k.reshape(bsz, n_b, win, n_kv, hd)
    vb = v.reshape(bsz, n_b, win, n_kv, hd)
    shift = ((0, 0), (1, 0), (0, 0), (0, 0), (0, 0))
    k_band = jnp.concatenate([jnp.pad(kb, shift)[:, :-1], kb], axis=2)
    v_band = jnp.concatenate([jnp.pad(vb, shift)[:, :-1], vb], axis=2)
    logits = jnp.einsum('bnqkgd,bnskd->bkgnqs', qb, k_band, preferred_element_type=jnp.float32) * (hd ** -0.5)
    dist = (jnp.arange(win)[:, None] + win) - jnp.arange(2 * win)[None, :]
    first = (jnp.arange(n_b) == 0)[:, None, None] & (jnp.arange(2 * win) < win)[None, None, :]
    allowed = ((dist >= 0) & (dist < win))[None] & ~first
    slopes = _alibi_slopes(n_h).reshape(1, n_kv, grp, 1, 1, 1)
    logits = jnp.where(allowed, logits - slopes * dist, -jnp.inf)
    sink = jnp.broadcast_to(sinks.astype(jnp.float32).reshape(1, n_kv, grp, 1, 1, 1), logits.shape[:-1] + (1,))
    w = jax.nn.softmax(jnp.concatenate([logits, sink], axis=-1), axis=-1)[..., :-1]
    o = jnp.einsum('bkgnqs,bnskd->bnqkgd', w.astype(v.dtype), v_band)
    return o.reshape(bsz, seq, n_h, hd)


def stick_breaking_attention(q, k, v):
    bsz, seq, n_h, hd = q.shape
    n_b = seq // SB_QBLOCK
    qh = q.transpose(0, 2, 1, 3)
    kh = k.transpose(0, 2, 1, 3)
    vh = v.transpose(0, 2, 1, 3)
    s_pos = jnp.arange(seq)
    scale = hd ** -0.5

    def block(c):
        q0 = c * SB_QBLOCK
        qc = lax.dynamic_slice_in_dim(qh, q0, SB_QBLOCK, axis=2)
        z = jnp.einsum('bhqd,bhsd->bhqs', qc, kh, preferred_element_type=jnp.float32) * scale
        strict = s_pos[None, :] < (q0 + jnp.arange(SB_QBLOCK))[:, None]
        log_keep = jnp.where(strict, jax.nn.log_sigmoid(-z), 0.0)
        after = lax.cumsum(log_keep, axis=3, reverse=True) - log_keep
        a = jnp.where(strict, jnp.exp(jax.nn.log_sigmoid(z) + after), 0.0)
        return jnp.einsum('bhqs,bhsd->bhqd', a.astype(vh.dtype), vh)

    out = lax.map(block, jnp.arange(n_b))
    return out.transpose(1, 0, 3, 2, 4).reshape(bsz, seq, n_h, hd)


def hierarchical_moe(x, w_grp, b_grp, w_exp, b_exp, w_e_gate, w_e_up, w_e_down):
    bsz, seq, d = x.shape
    xt = x.reshape(-1, d)
    n_tok = xt.shape[0]
    grp_prob = jax.nn.softmax((xt @ w_grp).astype(jnp.float32) + b_grp.astype(jnp.float32), axis=-1)
    g_p, g_idx = lax.top_k(grp_prob, 1)
    e_logits = ((xt @ w_exp).astype(jnp.float32) + b_exp.astype(jnp.float32)).reshape(n_tok, N_GROUPS, EXPERTS_PER_GROUP)
    in_grp = jnp.take_along_axis(e_logits, g_idx[:, :, None], axis=1)[:, 0]
    e_p, e_loc = lax.top_k(jax.nn.softmax(in_grp, axis=-1), TOPK_IN_GROUP)
    gate = g_p * (e_p / e_p.sum(-1, keepdims=True))
    e_glob = g_idx * EXPERTS_PER_GROUP + e_loc
    n_asg = n_tok * TOPK_IN_GROUP
    flat_e = e_glob.reshape(-1)
    flat_w = gate.reshape(-1)
    flat_tok = jnp.repeat(jnp.arange(n_tok), TOPK_IN_GROUP)
    order = jnp.argsort(flat_e)
    se = flat_e[order]
    counts = jnp.bincount(flat_e, length=N_EXPERTS)
    start = jnp.cumsum(counts) - counts
    pcounts = (counts + MOE_BLOCK - 1) // MOE_BLOCK * MOE_BLOCK
    pend = jnp.cumsum(pcounts)
    dest = (pend - pcounts)[se] + jnp.arange(n_asg) - start[se]
    n_pad = -(-n_asg // MOE_BLOCK) * MOE_BLOCK + N_EXPERTS * MOE_BLOCK
    n_blocks = n_pad // MOE_BLOCK
    tok_pad = jnp.zeros((n_pad,), jnp.int32).at[dest].set(flat_tok[order])
    w_pad = jnp.zeros((n_pad,), jnp.float32).at[dest].set(flat_w[order])
    block_e = jnp.minimum(jnp.searchsorted(pend, jnp.arange(n_blocks) * MOE_BLOCK, side='right'), N_EXPERTS - 1)

    def expert_block(args):
        xb, e = args
        h = jax.nn.silu(xb @ w_e_gate[e]) * (xb @ w_e_up[e])
        return h @ w_e_down[e]

    y = lax.map(expert_block, (xt[tok_pad].reshape(n_blocks, MOE_BLOCK, d), block_e))
    y = y.reshape(n_pad, d) * w_pad[:, None].astype(y.dtype)
    out = jnp.zeros_like(xt).at[tok_pad].add(y)
    return out.reshape(bsz, seq, d)


def setup_inputs(seed: int = 0) -> dict:
    key = jax.random.key(seed)
    ks = jax.random.split(key, 32)
    f32 = jnp.float32
    d = D_MODEL
    n_a, n_b, n_c = _n_layers_of(0), _n_layers_of(1), _n_layers_of(2)
    kv_w = SWA_KV_HEADS * HEAD_DIM

    def nrm(k, shape, scale):
        return jax.random.normal(k, shape, f32) * scale

    return {
        'x': nrm(ks[0], (BATCH, SEQ, d), 1.0),
        'p': nrm(ks[1], (DEPTH, BATCH, SEQ, PLE_DIM), 1.0),
        'w_qkv_a': nrm(ks[2], (n_a, d, 3 * d), d ** -0.5),
        'w_o_a': nrm(ks[3], (n_a, d, d), d ** -0.5 * DEEPNORM_BETA),
        'w_qkv_b': nrm(ks[4], (n_b, d, d + 2 * kv_w), d ** -0.5),
        'w_o_b': nrm(ks[5], (n_b, d, d), d ** -0.5 * DEEPNORM_BETA),
        'sinks_b': nrm(ks[6], (n_b, N_HEADS), 0.5),
        'w_qkv_c': nrm(ks[7], (n_c, d, 3 * d), d ** -0.5),
        'w_o_c': nrm(ks[8], (n_c, d, d), d ** -0.5 * DEEPNORM_BETA),
        'ln1_g': 1.0 + nrm(ks[9], (DEPTH, d), 0.02),
        'ln1_b': nrm(ks[10], (DEPTH, d), 0.02),
        'ln2_g': 1.0 + nrm(ks[11], (DEPTH, d), 0.02),
        'ln2_b': nrm(ks[12], (DEPTH, d), 0.02),
        'w_grp': nrm(ks[13], (DEPTH, d, N_GROUPS), d ** -0.5),
        'b_grp': nrm(ks[14], (DEPTH, N_GROUPS), 0.01),
        'w_exp': nrm(ks[15], (DEPTH, d, N_EXPERTS), d ** -0.5),
        'b_exp': nrm(ks[16], (DEPTH, N_EXPERTS), 0.01),
        'w_e_gate': nrm(ks[17], (DEPTH, N_EXPERTS, d, D_EXPERT), d ** -0.5),
        'w_e_up': nrm(ks[18], (DEPTH, N_EXPERTS, d, D_EXPERT), d ** -0.5),
        'w_e_down': nrm(ks[19], (DEPTH, N_EXPERTS, D_EXPERT, d), D_EXPERT ** -0.5 * DEEPNORM_BETA),
        'w_ple_gate': nrm(ks[20], (DEPTH, d, d), d ** -0.5),
        'w_ple_proj': nrm(ks[21], (DEPTH, PLE_DIM, d), PLE_DIM ** -0.5),
    }


def reference(x, p, w_qkv_a, w_o_a, w_qkv_b, w_o_b, sinks_b, w_qkv_c, w_o_c,
              ln1_g, ln1_b, ln2_g, ln2_b, w_grp, b_grp, w_exp, b_exp,
              w_e_gate, w_e_up, w_e_down, w_ple_gate, w_ple_proj):
    bsz, seq, d = x.shape
    kv_w = SWA_KV_HEADS * HEAD_DIM
    for i in range(DEPTH):
        mixer, j = i % N_MIXERS, i // N_MIXERS
        if mixer == 0:
            q, k, v = jnp.split(x @ w_qkv_a[j], 3, axis=-1)
            o = moba_attention(q.reshape(bsz, seq, N_HEADS, HEAD_DIM), k.reshape(bsz, seq, N_HEADS, HEAD_DIM),
                               v.reshape(bsz, seq, N_HEADS, HEAD_DIM))
            h = o.reshape(bsz, seq, d) @ w_o_a[j]
        elif mixer == 1:
            qkv = x @ w_qkv_b[j]
            q = qkv[..., :d].reshape(bsz, seq, N_HEADS, HEAD_DIM)
            k = qkv[..., d:d + kv_w].reshape(bsz, seq, SWA_KV_HEADS, HEAD_DIM)
            v = qkv[..., d + kv_w:].reshape(bsz, seq, SWA_KV_HEADS, HEAD_DIM)
            h = swa_gqa_attention(q, k, v, sinks_b[j]).reshape(bsz, seq, d) @ w_o_b[j]
        else:
            q, k, v = jnp.split(x @ w_qkv_c[j], 3, axis=-1)
            o = stick_breaking_attention(q.reshape(bsz, seq, N_HEADS, HEAD_DIM), k.reshape(bsz, seq, N_HEADS, HEAD_DIM),
                                         v.reshape(bsz, seq, N_HEADS, HEAD_DIM))
            h = o.reshape(bsz, seq, d) @ w_o_c[j]
        x = layer_norm(DEEPNORM_ALPHA * x + h, ln1_g[i], ln1_b[i])
        m = hierarchical_moe(x, w_grp[i], b_grp[i], w_exp[i], b_exp[i], w_e_gate[i], w_e_up[i], w_e_down[i])
        x = layer_norm(DEEPNORM_ALPHA * x + m, ln2_g[i], ln2_b[i])
        ple_gate = jax.nn.sigmoid((x @ w_ple_gate[i]).astype(jnp.float32)).astype(x.dtype)
        x = x + ple_gate * (p[i] @ w_ple_proj[i])
    return x
```

```cpp
#include <hip/hip_runtime.h>
#include <cstdint>
#include <cmath>

constexpr int D = 1024, BATCH = 16, SEQ = 2048, DEPTH = 4, M = BATCH * SEQ;
constexpr int HD = 64, NH = 16, NE = 32, DE = 512, PLE = 256;
constexpr int NSLOT = 65536 + 32 * 256;
constexpr int MOE_PAD = 256;
constexpr float ALPHA = 1.681792830507429f;
constexpr float LN_EPS = 1e-5f;

__global__ __launch_bounds__(256) void k_gemm_f32(const float* __restrict__ A, int lda, const float* __restrict__ B, int ldb, long strideB,
                                                   float* __restrict__ C, int ldc, int K, const int* __restrict__ a_rows, const int* __restrict__ tile_e)
{
    __shared__ float As[16][132];
    __shared__ float Bs[16][132];
    const int bm = blockIdx.y, bn = blockIdx.x, tid = threadIdx.x;
    const float* Bp = B;
    if (tile_e) { const int e = tile_e[bm]; if (e < 0) return; Bp = B + (long)e * strideB; }
    const int ty = tid >> 4, tx = tid & 15;
    const int ar = tid >> 1, ak = (tid & 1) * 8;
    const int grow = bm * 128 + ar;
    const long arow = a_rows ? (long)a_rows[grow] : (long)grow;
    const float* Ap = A + (arow >= 0 ? arow : 0) * (long)lda + ak;
    const bool aok = arow >= 0;
    const int bk = tid >> 4, bc = (tid & 15) * 8;
    const float* Bq = Bp + (long)bk * ldb + bn * 128 + bc;
    float acc[8][8];
#pragma unroll
    for (int i = 0; i < 8; ++i)
#pragma unroll
        for (int j = 0; j < 8; ++j) acc[i][j] = 0.f;
    for (int k0 = 0; k0 < K; k0 += 16) {
        float4 a0 = make_float4(0, 0, 0, 0), a1 = a0;
        if (aok) { a0 = *(const float4*)(Ap + k0); a1 = *(const float4*)(Ap + k0 + 4); }
        const float4 b0 = *(const float4*)(Bq + (long)k0 * ldb), b1 = *(const float4*)(Bq + (long)k0 * ldb + 4);
        __syncthreads();
        As[ak + 0][ar] = a0.x; As[ak + 1][ar] = a0.y; As[ak + 2][ar] = a0.z; As[ak + 3][ar] = a0.w;
        As[ak + 4][ar] = a1.x; As[ak + 5][ar] = a1.y; As[ak + 6][ar] = a1.z; As[ak + 7][ar] = a1.w;
        *(float4*)&Bs[bk][bc] = b0; *(float4*)&Bs[bk][bc + 4] = b1;
        __syncthreads();
#pragma unroll
        for (int kk = 0; kk < 16; ++kk) {
            const float4 x0 = *(const float4*)&As[kk][ty * 8], x1 = *(const float4*)&As[kk][ty * 8 + 4];
            const float4 y0 = *(const float4*)&Bs[kk][tx * 8], y1 = *(const float4*)&Bs[kk][tx * 8 + 4];
            const float a[8] = {x0.x, x0.y, x0.z, x0.w, x1.x, x1.y, x1.z, x1.w};
            const float b[8] = {y0.x, y0.y, y0.z, y0.w, y1.x, y1.y, y1.z, y1.w};
#pragma unroll
            for (int i = 0; i < 8; ++i)
#pragma unroll
                for (int j = 0; j < 8; ++j) acc[i][j] = fmaf(a[i], b[j], acc[i][j]);
        }
    }
#pragma unroll
    for (int i = 0; i < 8; ++i) {
        float* cp = C + (long)(bm * 128 + ty * 8 + i) * ldc + bn * 128 + tx * 8;
        *(float4*)cp = make_float4(acc[i][0], acc[i][1], acc[i][2], acc[i][3]);
        *(float4*)(cp + 4) = make_float4(acc[i][4], acc[i][5], acc[i][6], acc[i][7]);
    }
}

__global__ __launch_bounds__(256) void k_kmean(const float* __restrict__ Kp, int ldk, float* __restrict__ kmean)
{
    const int n = blockIdx.x, b = blockIdx.y, c = threadIdx.x * 4;
    float4 s = make_float4(0, 0, 0, 0);
    for (int r = 0; r < 256; ++r) {
        const float4 v = *(const float4*)(Kp + (long)(b * SEQ + n * 256 + r) * ldk + c);
        s.x += v.x; s.y += v.y; s.z += v.z; s.w += v.w;
    }
    const float inv = 1.f / 256.f;
    const int h = c >> 6, d = c & 63;
    *(float4*)(kmean + (((long)(b * NH + h) * 8 + n) * 64 + d)) = make_float4(s.x * inv, s.y * inv, s.z * inv, s.w * inv);
}

template <int MODE>
__global__ __launch_bounds__(256) void k_attn(const float* __restrict__ Q, int ldq, const float* __restrict__ Kp, const float* __restrict__ Vp, int ldkv, int kvdiv,
                                               float* __restrict__ O, const float* __restrict__ kmean, const float* __restrict__ sinks)
{
    __shared__ float Ks[64][64];
    __shared__ float Vs[64][64];
    const int c = blockIdx.x, h = blockIdx.y, b = blockIdx.z, tid = threadIdx.x;
    const int t = c * 256 + tid;
    const float slope = exp2f(-8.0f * (float)(h + 1) / 16.0f);
    float q[64], o[64];
    {
        const float* qp = Q + (long)(b * SEQ + t) * ldq + h * 64;
#pragma unroll
        for (int d = 0; d < 64; d += 4) { const float4 v = *(const float4*)(qp + d); q[d] = v.x; q[d + 1] = v.y; q[d + 2] = v.z; q[d + 3] = v.w; }
    }
#pragma unroll
    for (int d = 0; d < 64; ++d) o[d] = 0.f;
    unsigned selmask = 0;
    if (MODE == 0) {
        float g[8];
#pragma unroll
        for (int n = 0; n < 8; ++n) {
            float s = 0.f;
            if (n < c) {
                const float* km = kmean + (((long)(b * NH + h) * 8 + n) * 64);
#pragma unroll
                for (int d = 0; d < 64; ++d) s = fmaf(q[d], km[d], s);
            }
            g[n] = s;
        }
#pragma unroll
        for (int r = 0; r < 3; ++r) {
            float best = -INFINITY; int bi = -1;
#pragma unroll
            for (int n = 0; n < 8; ++n) { const bool cand = (n < c) && !((selmask >> n) & 1u) && (g[n] > best); if (cand) { best = g[n]; bi = n; } }
            if (bi >= 0) selmask |= 1u << bi;
        }
    }
    float m = -INFINITY, l = 0.f, after = 0.f;
    if (MODE == 1) { m = sinks[h]; l = 1.f; }
    int tile_lo, tile_hi;
    if (MODE == 0) { tile_lo = 0; tile_hi = 4 * c + 3; }
    else if (MODE == 1) { tile_lo = 4 * c - 2 < 0 ? 0 : 4 * c - 2; tile_hi = 4 * c + 3; }
    else { tile_lo = 0; tile_hi = 4 * c + 3; }
    const int kvh = h / kvdiv;
    for (int it = 0; it <= tile_hi - tile_lo; ++it) {
        const int tile = (MODE == 2) ? (tile_hi - it) : (tile_lo + it);
        __syncthreads();
#pragma unroll
        for (int i = 0; i < 4; ++i) {
            const int e = (i * 256 + tid) * 4, r = e >> 6, d = e & 63;
            const long off = (long)(b * SEQ + tile * 64 + r) * ldkv + kvh * 64 + d;
            *(float4*)&Ks[r][d] = *(const float4*)(Kp + off);
            *(float4*)&Vs[r][d] = *(const float4*)(Vp + off);
        }
        __syncthreads();
        for (int jj = 0; jj < 64; ++jj) {
            const int j = (MODE == 2) ? (63 - jj) : jj;
            const int s = tile * 64 + j;
            bool valid;
            if (MODE == 0) { const int n = tile >> 2; valid = (n == c) ? (s <= t) : (((selmask >> n) & 1u) != 0u); }
            else if (MODE == 1) { valid = (t - s >= 0) && (t - s < 128); }
            else { valid = s < t; }
            if (valid) {
                float dot = 0.f;
#pragma unroll
                for (int d = 0; d < 64; d += 4) { const float4 kk = *(const float4*)&Ks[j][d]; dot = fmaf(q[d], kk.x, dot); dot = fmaf(q[d + 1], kk.y, dot); dot = fmaf(q[d + 2], kk.z, dot); dot = fmaf(q[d + 3], kk.w, dot); }
                float p;
                if (MODE == 2) {
                    const float z = dot * 0.125f;
                    const float sp = fmaxf(z, 0.f) + log1pf(expf(-fabsf(z)));
                    p = expf(z - sp + after);
                    after -= sp;
                } else {
                    const float lg = dot * 0.125f - slope * (float)(t - s);
                    if (lg > m) { const float cs = expf(m - lg); l *= cs;
#pragma unroll
                        for (int d = 0; d < 64; ++d) o[d] *= cs;
                        m = lg; }
                    p = expf(lg - m); l += p;
                }
#pragma unroll
                for (int d = 0; d < 64; d += 4) { const float4 vv = *(const float4*)&Vs[j][d]; o[d] = fmaf(p, vv.x, o[d]); o[d + 1] = fmaf(p, vv.y, o[d + 1]); o[d + 2] = fmaf(p, vv.z, o[d + 2]); o[d + 3] = fmaf(p, vv.w, o[d + 3]); }
            }
        }
    }
    const float inv = (MODE == 2) ? 1.f : 1.f / l;
    float* op = O + (long)(b * SEQ + t) * D + h * 64;
#pragma unroll
    for (int d = 0; d < 64; d += 4) *(float4*)(op + d) = make_float4(o[d] * inv, o[d + 1] * inv, o[d + 2] * inv, o[d + 3] * inv);
}

__device__ __forceinline__ float wave_sum(float v) {
#pragma unroll
    for (int o = 32; o >= 1; o >>= 1) v += __shfl_xor(v, o);
    return v;
}

__global__ __launch_bounds__(256) void k_ln1(const float* __restrict__ x, const float* __restrict__ hbuf, const float* __restrict__ g, const float* __restrict__ bb, float* __restrict__ xo)
{
    const int row = blockIdx.x * 4 + (threadIdx.x >> 6), lane = threadIdx.x & 63;
    float y[16]; float s = 0.f;
#pragma unroll
    for (int i = 0; i < 4; ++i) {
        const int col = (i * 64 + lane) * 4;
        const float4 a = *(const float4*)(x + (long)row * D + col), hh = *(const float4*)(hbuf + (long)row * D + col);
        y[4 * i] = ALPHA * a.x + hh.x; y[4 * i + 1] = ALPHA * a.y + hh.y; y[4 * i + 2] = ALPHA * a.z + hh.z; y[4 * i + 3] = ALPHA * a.w + hh.w;
        s += (y[4 * i] + y[4 * i + 1]) + (y[4 * i + 2] + y[4 * i + 3]);
    }
    const float mu = wave_sum(s) * (1.f / D);
    float qv = 0.f;
#pragma unroll
    for (int i = 0; i < 16; ++i) { const float dd = y[i] - mu; qv = fmaf(dd, dd, qv); }
    const float rstd = 1.0f / sqrtf(wave_sum(qv) * (1.f / D) + LN_EPS);
#pragma unroll
    for (int i = 0; i < 4; ++i) {
        const int col = (i * 64 + lane) * 4;
        const float4 gg = *(const float4*)(g + col), b4 = *(const float4*)(bb + col);
        *(float4*)(xo + (long)row * D + col) = make_float4((y[4 * i] - mu) * rstd * gg.x + b4.x, (y[4 * i + 1] - mu) * rstd * gg.y + b4.y,
                                                           (y[4 * i + 2] - mu) * rstd * gg.z + b4.z, (y[4 * i + 3] - mu) * rstd * gg.w + b4.w);
    }
}

struct TokInfo { int e0, p0, e1, p1; float g0, g1; int pad0, pad1; };
__global__ __launch_bounds__(256) void k_route(const float* __restrict__ x, const float* __restrict__ wg, const float* __restrict__ bg, const float* __restrict__ we, const float* __restrict__ be,
                                                int* __restrict__ cnt, int* __restrict__ list, TokInfo* __restrict__ ti)
{
    const int tok = blockIdx.x * 4 + (threadIdx.x >> 6), lane = threadIdx.x & 63;
    float acc[36];
#pragma unroll
    for (int j = 0; j < 36; ++j) acc[j] = 0.f;
    const float* xr = x + (long)tok * D + lane * 16;
#pragma unroll
    for (int kk = 0; kk < 16; kk += 4) {
        const float4 xv = *(const float4*)(xr + kk);
        const float xs[4] = {xv.x, xv.y, xv.z, xv.w};
#pragma unroll
        for (int u = 0; u < 4; ++u) {
            const int k = lane * 16 + kk + u;
            const float4 g4 = *(const float4*)(wg + (long)k * 4);
            acc[0] = fmaf(xs[u], g4.x, acc[0]); acc[1] = fmaf(xs[u], g4.y, acc[1]); acc[2] = fmaf(xs[u], g4.z, acc[2]); acc[3] = fmaf(xs[u], g4.w, acc[3]);
#pragma unroll
            for (int j = 0; j < 32; j += 4) {
                const float4 e4 = *(const float4*)(we + (long)k * 32 + j);
                acc[4 + j] = fmaf(xs[u], e4.x, acc[4 + j]); acc[5 + j] = fmaf(xs[u], e4.y, acc[5 + j]); acc[6 + j] = fmaf(xs[u], e4.z, acc[6 + j]); acc[7 + j] = fmaf(xs[u], e4.w, acc[7 + j]);
            }
        }
    }
#pragma unroll
    for (int j = 0; j < 36; ++j) acc[j] = wave_sum(acc[j]);
    float gl[4];
#pragma unroll
    for (int j = 0; j < 4; ++j) gl[j] = acc[j] + bg[j];
    int gi = 0; float gm = gl[0];
#pragma unroll
    for (int j = 1; j < 4; ++j) if (gl[j] > gm) { gm = gl[j]; gi = j; }
    float gs = 0.f;
#pragma unroll
    for (int j = 0; j < 4; ++j) gs += expf(gl[j] - gm);
    const float gp = 1.f / gs;
    float el[8];
#pragma unroll
    for (int j = 0; j < 8; ++j) {
        float v = acc[4 + j];
#pragma unroll
        for (int gq = 1; gq < 4; ++gq) v = (gi == gq) ? acc[4 + gq * 8 + j] : v;
        el[j] = v + be[gi * 8 + j];
    }
    int i0 = 0; float m0 = el[0];
#pragma unroll
    for (int j = 1; j < 8; ++j) if (el[j] > m0) { m0 = el[j]; i0 = j; }
    int i1 = -1; float m1 = -INFINITY;
#pragma unroll
    for (int j = 0; j < 8; ++j) if (j != i0 && el[j] > m1) { m1 = el[j]; i1 = j; }
    const float p1 = expf(m1 - m0);
    const float w0 = gp / (1.f + p1), w1 = gp * p1 / (1.f + p1);
    if (lane == 0) {
        const int e0 = gi * 8 + i0, e1 = gi * 8 + i1;
        const int q0 = atomicAdd(&cnt[e0], 1), q1 = atomicAdd(&cnt[e1], 1);
        list[e0 * M + q0] = tok; list[e1 * M + q1] = tok;
        TokInfo t; t.e0 = e0; t.p0 = q0; t.e1 = e1; t.p1 = q1; t.g0 = w0; t.g1 = w1; t.pad0 = 0; t.pad1 = 0;
        ti[tok] = t;
    }
}
__global__ void k_moe_off(const int* __restrict__ cnt, int* __restrict__ off, int* __restrict__ tile_e)
{
    __shared__ int so[33];
    if (threadIdx.x == 0) { int a = 0; for (int e = 0; e < 32; ++e) { so[e] = a; a += (cnt[e] + MOE_PAD - 1) / MOE_PAD * MOE_PAD; } so[32] = a; }
    __syncthreads();
    if (threadIdx.x < 33) off[threadIdx.x] = so[threadIdx.x];
    for (int t = threadIdx.x; t < NSLOT / 128; t += blockDim.x) {
        int e = -1;
        for (int k = 0; k < 32; ++k) if (t * 128 >= so[k] && t * 128 < so[k] + cnt[k]) e = k;
        tile_e[t] = e;
    }
}
__global__ void k_moe_fill(const TokInfo* __restrict__ ti, const int* __restrict__ off, int* __restrict__ slot2tok)
{
    const int tok = blockIdx.x * blockDim.x + threadIdx.x;
    const TokInfo t = ti[tok];
    slot2tok[off[t.e0] + t.p0] = tok; slot2tok[off[t.e1] + t.p1] = tok;
}
__global__ void k_silu_mul(const float* __restrict__ G, const float* __restrict__ U, float* __restrict__ H, long n4)
{
    const long i = (long)blockIdx.x * blockDim.x + threadIdx.x; if (i >= n4) return;
    const float4 g = ((const float4*)G)[i], u = ((const float4*)U)[i];
    float4 r; r.x = g.x / (1.f + expf(-g.x)) * u.x; r.y = g.y / (1.f + expf(-g.y)) * u.y; r.z = g.z / (1.f + expf(-g.z)) * u.z; r.w = g.w / (1.f + expf(-g.w)) * u.w;
    ((float4*)H)[i] = r;
}
__global__ __launch_bounds__(256) void k_ln2(const float* __restrict__ x, const float* __restrict__ Y, const TokInfo* __restrict__ ti, const int* __restrict__ off,
                                              const float* __restrict__ g, const float* __restrict__ bb, float* __restrict__ xo)
{
    const int row = blockIdx.x * 4 + (threadIdx.x >> 6), lane = threadIdx.x & 63;
    const TokInfo t = ti[row];
    const float* y0 = Y + (long)(off[t.e0] + t.p0) * D; const float* y1 = Y + (long)(off[t.e1] + t.p1) * D;
    float y[16]; float s = 0.f;
#pragma unroll
    for (int i = 0; i < 4; ++i) {
        const int col = (i * 64 + lane) * 4;
        const float4 a = *(const float4*)(x + (long)row * D + col), u = *(const float4*)(y0 + col), v = *(const float4*)(y1 + col);
        y[4 * i] = ALPHA * a.x + (t.g0 * u.x + t.g1 * v.x); y[4 * i + 1] = ALPHA * a.y + (t.g0 * u.y + t.g1 * v.y);
        y[4 * i + 2] = ALPHA * a.z + (t.g0 * u.z + t.g1 * v.z); y[4 * i + 3] = ALPHA * a.w + (t.g0 * u.w + t.g1 * v.w);
        s += (y[4 * i] + y[4 * i + 1]) + (y[4 * i + 2] + y[4 * i + 3]);
    }
    const float mu = wave_sum(s) * (1.f / D);
    float qv = 0.f;
#pragma unroll
    for (int i = 0; i < 16; ++i) { const float dd = y[i] - mu; qv = fmaf(dd, dd, qv); }
    const float rstd = 1.0f / sqrtf(wave_sum(qv) * (1.f / D) + LN_EPS);
#pragma unroll
    for (int i = 0; i < 4; ++i) {
        const int col = (i * 64 + lane) * 4;
        const float4 gg = *(const float4*)(g + col), b4 = *(const float4*)(bb + col);
        *(float4*)(xo + (long)row * D + col) = make_float4((y[4 * i] - mu) * rstd * gg.x + b4.x, (y[4 * i + 1] - mu) * rstd * gg.y + b4.y,
                                                           (y[4 * i + 2] - mu) * rstd * gg.z + b4.z, (y[4 * i + 3] - mu) * rstd * gg.w + b4.w);
    }
}
__global__ void k_ple(const float* __restrict__ x, const float* __restrict__ G, const float* __restrict__ PP, float* __restrict__ xo, long n4)
{
    const long i = (long)blockIdx.x * blockDim.x + threadIdx.x; if (i >= n4) return;
    const float4 a = ((const float4*)x)[i], g = ((const float4*)G)[i], p = ((const float4*)PP)[i];
    float4 r; r.x = a.x + p.x / (1.f + expf(-g.x)); r.y = a.y + p.y / (1.f + expf(-g.y)); r.z = a.z + p.z / (1.f + expf(-g.z)); r.w = a.w + p.w / (1.f + expf(-g.w));
    ((float4*)xo)[i] = r;
}

static void gemm(hipStream_t st, const float* A, int lda, const float* B, int ldb, long strideB, float* C, int ldc, int Mr, int N, int K, const int* a_rows, const int* tile_e)
{
    hipLaunchKernelGGL(k_gemm_f32, dim3(N / 128, Mr / 128), dim3(256), 0, st, A, lda, B, ldb, strideB, C, ldc, K, a_rows, tile_e);
}

extern "C" void kernel_launch(void* const* d_in, const int* in_sizes, int n_in, void* d_out, int out_size, void* d_ws, size_t ws_size, hipStream_t stream)
{
    const float* x_in = (const float*)d_in[0];
    const float* p_in = (const float*)d_in[1];
    const float* w_qkv_a = (const float*)d_in[2];  const float* w_o_a = (const float*)d_in[3];
    const float* w_qkv_b = (const float*)d_in[4];  const float* w_o_b = (const float*)d_in[5];
    const float* sinks_b = (const float*)d_in[6];
    const float* w_qkv_c = (const float*)d_in[7];  const float* w_o_c = (const float*)d_in[8];
    const float* ln1_g = (const float*)d_in[9];    const float* ln1_b = (const float*)d_in[10];
    const float* ln2_g = (const float*)d_in[11];   const float* ln2_b = (const float*)d_in[12];
    const float* w_grp = (const float*)d_in[13];   const float* b_grp = (const float*)d_in[14];
    const float* w_exp = (const float*)d_in[15];   const float* b_exp = (const float*)d_in[16];
    const float* w_e_gate = (const float*)d_in[17]; const float* w_e_up = (const float*)d_in[18]; const float* w_e_down = (const float*)d_in[19];
    const float* w_ple_gate = (const float*)d_in[20]; const float* w_ple_proj = (const float*)d_in[21];
    float* out = (float*)d_out;

    char* ws = (char*)d_ws;
    const size_t MiB = 1u << 20;
    int* cnt = (int*)(ws + 0);
    int* off = (int*)(ws + 4096);
    int* tile_e = (int*)(ws + 8192);
    float* kmean = (float*)(ws + 1 * MiB);
    TokInfo* ti = (TokInfo*)(ws + 2 * MiB);
    int* slot2tok = (int*)(ws + 3 * MiB);
    int* list = (int*)(ws + 4 * MiB);
    float* XA = (float*)(ws + 8 * MiB);
    float* XB = (float*)(ws + 136 * MiB);
    float* T = (float*)(ws + 264 * MiB);
    float* QKV = (float*)(ws + 392 * MiB);
    float* O = (float*)(ws + 776 * MiB);
    float* Gb = (float*)(ws + 392 * MiB);
    float* Ub = (float*)(ws + 536 * MiB);
    float* Yb = (float*)(ws + 680 * MiB);

    const float* xcur = x_in;
    for (int i = 0; i < DEPTH; ++i) {
        const int mixer = i % 3, j = i / 3;
        const float* wo;
        if (mixer == 0) {
            gemm(stream, xcur, D, w_qkv_a + (size_t)j * D * 3 * D, 3 * D, 0, QKV, 3 * D, M, 3 * D, D, nullptr, nullptr);
            hipLaunchKernelGGL(k_kmean, dim3(8, 16), dim3(256), 0, stream, QKV + D, 3 * D, kmean);
            hipLaunchKernelGGL(k_attn<0>, dim3(8, 16, 16), dim3(256), 0, stream, QKV, 3 * D, QKV + D, QKV + 2 * D, 3 * D, 1, O, kmean, (const float*)nullptr);
            wo = w_o_a + (size_t)j * D * D;
        } else if (mixer == 1) {
            gemm(stream, xcur, D, w_qkv_b + (size_t)j * D * 1536, 1536, 0, QKV, 1536, M, 1536, D, nullptr, nullptr);
            hipLaunchKernelGGL(k_attn<1>, dim3(8, 16, 16), dim3(256), 0, stream, QKV, 1536, QKV + D, QKV + D + 256, 1536, 4, O, (const float*)nullptr, sinks_b + j * NH);
            wo = w_o_b + (size_t)j * D * D;
        } else {
            gemm(stream, xcur, D, w_qkv_c + (size_t)j * D * 3 * D, 3 * D, 0, QKV, 3 * D, M, 3 * D, D, nullptr, nullptr);
            hipLaunchKernelGGL(k_attn<2>, dim3(8, 16, 16), dim3(256), 0, stream, QKV, 3 * D, QKV + D, QKV + 2 * D, 3 * D, 1, O, (const float*)nullptr, (const float*)nullptr);
            wo = w_o_c + (size_t)j * D * D;
        }
        gemm(stream, O, D, wo, D, 0, T, D, M, D, D, nullptr, nullptr);
        hipLaunchKernelGGL(k_ln1, dim3(M / 4), dim3(256), 0, stream, xcur, T, ln1_g + i * D, ln1_b + i * D, XA);
        hipMemsetAsync(cnt, 0, 32 * sizeof(int), stream);
        hipMemsetAsync(slot2tok, 0xFF, NSLOT * sizeof(int), stream);
        hipLaunchKernelGGL(k_route, dim3(M / 4), dim3(256), 0, stream, XA, w_grp + (size_t)i * D * 4, b_grp + i * 4, w_exp + (size_t)i * D * 32, b_exp + i * 32, cnt, list, ti);
        hipLaunchKernelGGL(k_moe_off, dim3(1), dim3(256), 0, stream, cnt, off, tile_e);
        hipLaunchKernelGGL(k_moe_fill, dim3(M / 256), dim3(256), 0, stream, ti, off, slot2tok);
        gemm(stream, XA, D, w_e_gate + (size_t)i * NE * D * DE, DE, (long)D * DE, Gb, DE, NSLOT, DE, D, slot2tok, tile_e);
        gemm(stream, XA, D, w_e_up + (size_t)i * NE * D * DE, DE, (long)D * DE, Ub, DE, NSLOT, DE, D, slot2tok, tile_e);
        { const long n4 = (long)NSLOT * DE / 4; hipLaunchKernelGGL(k_silu_mul, dim3((unsigned)((n4 + 255) / 256)), dim3(256), 0, stream, Gb, Ub, Gb, n4); }
        gemm(stream, Gb, DE, w_e_down + (size_t)i * NE * DE * D, D, (long)DE * D, Yb, D, NSLOT, D, DE, nullptr, tile_e);
        hipLaunchKernelGGL(k_ln2, dim3(M / 4), dim3(256), 0, stream, XA, Yb, ti, off, ln2_g + i * D, ln2_b + i * D, XB);
        gemm(stream, XB, D, w_ple_gate + (size_t)i * D * D, D, 0, T, D, M, D, D, nullptr, nullptr);
        gemm(stream, p_in + (size_t)i * M * PLE, PLE, w_ple_proj + (size_t)i * PLE * D, D, 0, O, D, M, D, PLE, nullptr, nullptr);
        float* xn = (i == DEPTH - 1) ? out : XA;
        { const long n4 = (long)M * D / 4; hipLaunchKernelGGL(k_ple, dim3((unsigned)((n4 + 255) / 256)), dim3(256), 0, stream, XB, T, O, xn, n4); }
        xcur = xn;
    }
}
```

```cpp
#include <hip/hip_runtime.h>
#include <cstdint>
#include <cstdio>
#include <cmath>

#define LAS __attribute__((address_space(3)))
#define GAS __attribute__((address_space(1)))
typedef unsigned short bf16_t;
typedef short bf16x8 __attribute__((ext_vector_type(8)));
typedef float f32x4 __attribute__((ext_vector_type(4)));
typedef float f32x2 __attribute__((ext_vector_type(2)));
typedef unsigned u32x4 __attribute__((ext_vector_type(4)));
typedef unsigned u32x2 __attribute__((ext_vector_type(2)));

constexpr int D = 1024, BATCH = 16, SEQ = 2048, DEPTH = 4, M = BATCH * SEQ;
constexpr int HD = 64, NH = 16, NE = 32, DE = 512, PLE = 256;
constexpr int NSLOT = 65536 + 32 * 256;
constexpr float ALPHA = 1.681792830507429f;
constexpr float LN_EPS = 1e-5f;
constexpr float LOG2E = 1.4426950408889634f;
constexpr int NWAVES = 8, NTHREADS = 512;
constexpr int NPH = 10;

constexpr size_t MiB = 1u << 20;
constexpr size_t WS_CTL = 0, CTL_ZERO_BYTES = 2 * MiB;
constexpr size_t WS_TI = 2 * MiB;
constexpr size_t WS_KMEAN = 3 * MiB;
constexpr size_t WS_LIST = 4 * MiB;
constexpr size_t WS_WQKV = 8 * MiB;
constexpr size_t WS_WO = 14 * MiB;
constexpr size_t WS_W1 = 16 * MiB;
constexpr size_t WS_W2 = 80 * MiB;
constexpr size_t WS_WPG = 112 * MiB;
constexpr size_t WS_WPP = 114 * MiB;
constexpr size_t WS_PB = 115 * MiB;
constexpr size_t WS_X = 132 * MiB;
constexpr size_t WS_XBA = 260 * MiB, WS_XBB = 324 * MiB;
constexpr size_t WS_R = 388 * MiB;
constexpr size_t WS_QKV = WS_R, WS_O = WS_R + 192 * MiB, WS_T = WS_R, WS_H = WS_R, WS_Y = WS_R + 72 * MiB;
constexpr size_t WS_PP = 644 * MiB;
constexpr size_t WS_END = 708 * MiB;
constexpr int CW_TMO = 0;
constexpr int CW_BAR = 4096;
constexpr int CW_CNT = 1024;

struct TokInfo { int e0, p0, e1, p1; float g0, g1; int pad0, pad1; };

constexpr int RING_BYTES = 131072;
constexpr int ROUTER_TBL_BYTES = 1024 * 36 * 4;
constexpr int MISC_OFF = 147456;
constexpr int MISC_BAR = 0;
constexpr int MISC_TBL = 16;
constexpr int LDS_BYTES = MISC_OFF + 1024;

__device__ __forceinline__ float bf2f(bf16_t v) { return __uint_as_float((unsigned)v << 16); }
__device__ __forceinline__ unsigned cvt_pk_bf16(float lo, float hi) { unsigned r; asm volatile("v_cvt_pk_bf16_f32 %0, %1, %2" : "=v"(r) : "v"(lo), "v"(hi)); return r; }
__device__ __forceinline__ float wave_sum(float v) {
#pragma unroll
    for (int o = 1; o < 64; o <<= 1) v += __shfl_xor(v, o);
    return v;
}

namespace pg8 {
#define PG8_LAS __attribute__((address_space(3)))
constexpr int BM = 256, BK = 64, HALF = 128, HTB = HALF * BK * 2  , STAGE_BYTES = 8 * HTB, NXCD = 8, WGM = 8;

__host__ __device__ __forceinline__ int lds_byte(int r, int c) { const int st = (r >> 4) * 2 + (c >> 5), rr = r & 15, cc = c & 31, ob = rr * 64 + cc * 2; return st * 1024 + (ob ^ (((ob >> 9) & 1) << 5)); }
__host__ __device__ __forceinline__ void stage_rc(int b, int& R, int& C) { const int st = b / 1024, sb = b % 1024, swz = sb ^ (((sb >> 9) & 1) << 5); R = (st >> 1) * 16 + swz / 64; C = (st & 1) * 32 + (swz % 64) / 2; }
__host__ __device__ __forceinline__ int perm32(int rho) { const int n = rho >> 4, i = rho & 15; return 8 * (i >> 2) + 4 * n + (i & 3); }

struct Unit { int pm, pn, e, lt; };

struct DenseOrder {
    const bf16_t* A; const bf16_t* Bt; int K;
    int nM, nN, nwg, G, c;
    __device__ __forceinline__ void init(const bf16_t* A_, const bf16_t* Bt_, int M_, int N_, int K_, int G_, int c_) { A = A_; Bt = Bt_; K = K_; nM = M_ / BM; nN = N_ / BM; nwg = nM * nN; G = G_; c = c_; }
    __device__ __forceinline__ bool next(int i, Unit& u) const {
        const long L = (long)i * G + c; if (L >= nwg) return false;
        int wgid = (int)L; { const int q = nwg / NXCD, r = nwg % NXCD, xcd = wgid % NXCD, off = wgid / NXCD; wgid = (xcd < r ? xcd * (q + 1) : r * (q + 1) + (xcd - r) * q) + off; }
        const int nig = WGM * nN, gid = wgid / nig, fm = gid * WGM, gsz = (nM - fm) < WGM ? (nM - fm) : WGM;
        u.pm = fm + ((wgid % nig) % gsz); u.pn = (wgid % nig) / gsz; u.e = 0; u.lt = 0; return true;
    }
    __device__ __forceinline__ const char* a_ptr(const Unit& u) const { return (const char*)A + (size_t)u.pm * BM * K * 2; }
    __device__ __forceinline__ const char* b_ptr(const Unit& u) const { return (const char*)Bt + (size_t)u.pn * BM * K * 2; }
    __device__ __forceinline__ int row_tok(const Unit&, int) const { return 0; }
};
struct MoeOrder {
    const bf16_t* A; const bf16_t* Bt; int K; size_t strideB;
    const int* list; PG8_LAS const int* tbl; int G, c;
    __device__ __forceinline__ bool next(int i, Unit& u) const {
        const int L = i * G + c, rt = L >> 2; if (rt >= tbl[32]) return false;
        u.pn = L & 3; int e = 0;
#pragma unroll
        for (int k = 1; k < 32; ++k) e += (rt >= tbl[k]) ? 1 : 0;
        u.e = e; u.lt = rt - tbl[e]; u.pm = rt; return true;
    }
    __device__ __forceinline__ const char* a_ptr(const Unit& u) const { return (const char*)A; }
    __device__ __forceinline__ const char* a_ptr_compact(const Unit& u) const { return (const char*)A + (size_t)u.pm * BM * K * 2; }
    __device__ __forceinline__ const char* b_ptr(const Unit& u) const { return (const char*)Bt + ((size_t)u.e * strideB + (size_t)u.pn * BM * K) * 2; }
    __device__ __forceinline__ int row_tok(const Unit& u, int r) const { const int pos = u.lt * BM + r; return pos < tbl[33 + u.e] ? list[(size_t)u.e * M + pos] : 0; }
};
struct MoeOrder2 : MoeOrder {
    __device__ __forceinline__ const char* a_ptr(const Unit& u) const { return a_ptr_compact(u); }
};

struct EpiStoreBf16 {
    static constexpr bool PERM = true;
    bf16_t* O; int ldc; float scale0; int scale_cols;
    __device__ __forceinline__ void operator()(const f32x4 (&acc)[2][2][4][2], const Unit& u, int wr, int wc, int fr, int fq) const {
        const int row0 = u.pm * BM + wr * 64 + fr, col0 = u.pn * BM + wc * 32 + 8 * fq;
        const float sc = (u.pn * BM < scale_cols) ? scale0 : 1.f;
#pragma unroll
        for (int ai = 0; ai < 2; ++ai)
#pragma unroll
            for (int m = 0; m < 4; ++m) { bf16_t* rowp = O + (size_t)(row0 + ai * HALF + m * 16) * ldc + col0;
#pragma unroll
                for (int bj = 0; bj < 2; ++bj) { const f32x4 v0 = acc[ai][bj][m][0] * sc, v1 = acc[ai][bj][m][1] * sc;
                    u32x4 w; w.x = cvt_pk_bf16(v0[0], v0[1]); w.y = cvt_pk_bf16(v0[2], v0[3]); w.z = cvt_pk_bf16(v1[0], v1[1]); w.w = cvt_pk_bf16(v1[2], v1[3]);
                    *(u32x4*)(rowp + bj * HALF) = w; } }
    }
};
struct EpiResF32 {
    static constexpr bool PERM = false;
    const float* xres; float* T;
    __device__ __forceinline__ void operator()(const f32x4 (&acc)[2][2][4][2], const Unit& u, int wr, int wc, int fr, int fq) const {
        const int row0 = u.pm * BM + wr * 64 + fr, col0 = u.pn * BM + wc * 32 + 4 * fq;
#pragma unroll
        for (int ai = 0; ai < 2; ++ai)
#pragma unroll
            for (int m = 0; m < 4; ++m) { const size_t off = (size_t)(row0 + ai * HALF + m * 16) * D + col0;
#pragma unroll
                for (int bj = 0; bj < 2; ++bj)
#pragma unroll
                    for (int n = 0; n < 2; ++n) { const f32x4 xr = *(const f32x4*)(xres + off + bj * HALF + n * 16); *(f32x4*)(T + off + bj * HALF + n * 16) = xr * ALPHA + acc[ai][bj][m][n]; } }
    }
};
__device__ __forceinline__ float silu_f(float g) { return g * __builtin_amdgcn_rcpf(1.f + __builtin_amdgcn_exp2f(-g * LOG2E)); }
__device__ __forceinline__ float sigmoid_f(float g) { return __builtin_amdgcn_rcpf(1.f + __builtin_amdgcn_exp2f(-g * LOG2E)); }
struct EpiSwiglu {
    static constexpr bool PERM = true;
    bf16_t* H;
    __device__ __forceinline__ void operator()(const f32x4 (&acc)[2][2][4][2], const Unit& u, int wr, int wc, int fr, int fq) const {
        const int row0 = u.pm * BM + wr * 64 + fr, col0 = u.pn * HALF + wc * 32 + 8 * fq;
#pragma unroll
        for (int ai = 0; ai < 2; ++ai)
#pragma unroll
            for (int m = 0; m < 4; ++m) { bf16_t* rowp = H + (size_t)(row0 + ai * HALF + m * 16) * DE + col0;
                const f32x4 g0 = acc[ai][0][m][0], g1 = acc[ai][0][m][1], u0 = acc[ai][1][m][0], u1 = acc[ai][1][m][1];
                u32x4 w; w.x = cvt_pk_bf16(silu_f(g0[0]) * u0[0], silu_f(g0[1]) * u0[1]); w.y = cvt_pk_bf16(silu_f(g0[2]) * u0[2], silu_f(g0[3]) * u0[3]);
                w.z = cvt_pk_bf16(silu_f(g1[0]) * u1[0], silu_f(g1[1]) * u1[1]); w.w = cvt_pk_bf16(silu_f(g1[2]) * u1[2], silu_f(g1[3]) * u1[3]);
                *(u32x4*)rowp = w; }
    }
};
struct EpiPle {
    static constexpr bool PERM = true;
    const float* xin; float* xout; const bf16_t* PP; bf16_t* xb;
    __device__ __forceinline__ void operator()(const f32x4 (&acc)[2][2][4][2], const Unit& u, int wr, int wc, int fr, int fq) const {
        const int row0 = u.pm * BM + wr * 64 + fr, col0 = u.pn * BM + wc * 32 + 8 * fq;
#pragma unroll
        for (int ai = 0; ai < 2; ++ai)
#pragma unroll
            for (int m = 0; m < 4; ++m) { const size_t off = (size_t)(row0 + ai * HALF + m * 16) * D + col0;
#pragma unroll
                for (int bj = 0; bj < 2; ++bj) { const size_t o2 = off + bj * HALF;
                    const f32x4 x0 = *(const f32x4*)(xin + o2), x1 = *(const f32x4*)(xin + o2 + 4); const u32x4 pp = *(const u32x4*)(PP + o2);
                    const f32x4 a0 = acc[ai][bj][m][0], a1 = acc[ai][bj][m][1];
                    f32x4 r0, r1;
                    r0[0] = x0[0] + sigmoid_f(a0[0]) * __uint_as_float(pp.x << 16); r0[1] = x0[1] + sigmoid_f(a0[1]) * __uint_as_float(pp.x & 0xffff0000u);
                    r0[2] = x0[2] + sigmoid_f(a0[2]) * __uint_as_float(pp.y << 16); r0[3] = x0[3] + sigmoid_f(a0[3]) * __uint_as_float(pp.y & 0xffff0000u);
                    r1[0] = x1[0] + sigmoid_f(a1[0]) * __uint_as_float(pp.z << 16); r1[1] = x1[1] + sigmoid_f(a1[1]) * __uint_as_float(pp.z & 0xffff0000u);
                    r1[2] = x1[2] + sigmoid_f(a1[2]) * __uint_as_float(pp.w << 16); r1[3] = x1[3] + sigmoid_f(a1[3]) * __uint_as_float(pp.w & 0xffff0000u);
                    *(f32x4*)(xout + o2) = r0; *(f32x4*)(xout + o2 + 4) = r1;
                    u32x4 w; w.x = cvt_pk_bf16(r0[0], r0[1]); w.y = cvt_pk_bf16(r0[2], r0[3]); w.z = cvt_pk_bf16(r1[0], r1[1]); w.w = cvt_pk_bf16(r1[2], r1[3]);
                    *(u32x4*)(xb + o2) = w; } }
    }
};

template <class Epi, class Sched, bool ALIGN_EPI, bool GATHER>
__device__ __forceinline__ void gemm_phase(PG8_LAS unsigned char* lds, const int K, const Sched& S, const Epi& E, const int wave0) {
    int tid_ = wave0 * 64 + (int)__builtin_amdgcn_mbcnt_hi(~0u, __builtin_amdgcn_mbcnt_lo(~0u, 0u)); asm volatile("" : "+v"(tid_));
    const int tid = tid_, wid = __builtin_amdgcn_readfirstlane(tid >> 6), lane = tid & 63, wr = wid >> 2, wc = wid & 3, fr = lane & 15, fq = lane >> 4;
    const int nt = K / BK;
    unsigned voffB[2]; int RA[2]; unsigned CA2[2];
#pragma unroll
    for (int i = 0; i < 2; ++i) { int R, C; stage_rc(tid * 16 + i * 8192, R, C); const int Rb = Epi::PERM ? ((R & ~31) + perm32(R & 31)) : R;
        RA[i] = R; CA2[i] = (unsigned)C * 2u; voffB[i] = (unsigned)(Rb * K + C) * 2u; }
    const size_t kstep = (size_t)(BK * 2);
    const size_t hstep = (size_t)HALF * K * 2;
    const size_t hstepA = GATHER ? (size_t)0 : hstep;
    const unsigned ldsw = (unsigned)wid * 1024u;
    const int aoff = lds_byte(wr * 64 + fr, fq * 8), boff = lds_byte(wc * 32 + fr, fq * 8);
#define PG8_SA(b, h) (((b) * 2 + (h)) * HTB)
#define PG8_SB(b, h) ((4 + (b) * 2 + (h)) * HTB)
#define PG8_STAGE(bufoff, gbase, voff) do { _Pragma("unroll") for (int _i = 0; _i < 2; ++_i) \
        __builtin_amdgcn_global_load_lds((const unsigned*)((const char*)(gbase) + (voff)[_i]), (PG8_LAS unsigned*)(lds + (bufoff) + ldsw + _i * 8192), 16, 0, 0); } while (0)
#define PG8_LDA(dst, b, h) do { _Pragma("unroll") for (int m = 0; m < 4; ++m) _Pragma("unroll") for (int k = 0; k < 2; ++k) dst[m][k] = *(const PG8_LAS bf16x8*)(lds + PG8_SA(b, h) + aoff + m * 2048 + k * 1024); } while (0)
#define PG8_LDB(dst, b, h) do { _Pragma("unroll") for (int n = 0; n < 2; ++n) _Pragma("unroll") for (int k = 0; k < 2; ++k) dst[n][k] = *(const PG8_LAS bf16x8*)(lds + PG8_SB(b, h) + boff + n * 2048 + k * 1024); } while (0)
#define PG8_MMA(ai, bj, At, Bt) do { __builtin_amdgcn_s_setprio(1); _Pragma("unroll") for (int m = 0; m < 4; ++m) _Pragma("unroll") for (int n = 0; n < 2; ++n) _Pragma("unroll") for (int k = 0; k < 2; ++k) \
        acc[ai][bj][m][n] = __builtin_amdgcn_mfma_f32_16x16x32_bf16(Bt[n][k], At[m][k], acc[ai][bj][m][n], 0, 0, 0); __builtin_amdgcn_s_setprio(0); } while (0)
#define PG8_WAIT_V(n) asm volatile("s_waitcnt vmcnt(" #n ")" ::: "memory")
#define PG8_WAIT_L(n) asm volatile("s_waitcnt lgkmcnt(" #n ")" ::: "memory")
#define PG8_BAR __builtin_amdgcn_s_barrier()
#define PG8_SCHED __builtin_amdgcn_sched_barrier(0)
#define PG8_GOFF(dst, u) do { _Pragma("unroll") for (int _h = 0; _h < 2; ++_h) _Pragma("unroll") for (int _i = 0; _i < 2; ++_i) \
        dst[_h][_i] = GATHER ? ((unsigned)S.row_tok(u, _h * HALF + RA[_i]) * (unsigned)(K * 2) + CA2[_i]) : ((unsigned)(RA[_i] * K) * 2u + CA2[_i]); } while (0)
    Unit cur, nxt; int ui = 0;
    if (!S.next(0, cur)) return;
    f32x4 acc[2][2][4][2];
#pragma unroll
    for (int a = 0; a < 2; ++a)
#pragma unroll
        for (int b = 0; b < 2; ++b)
#pragma unroll
            for (int m = 0; m < 4; ++m)
#pragma unroll
                for (int n = 0; n < 2; ++n) acc[a][b][m][n] = (f32x4){0.f, 0.f, 0.f, 0.f};
    bf16x8 At[4][2], B0[2][2], B1[2][2];
    unsigned gc[2][2], gn[2][2];
    PG8_GOFF(gc, cur);
    const char* cA = S.a_ptr(cur); const char* cB = S.b_ptr(cur);
    PG8_STAGE(PG8_SB(0, 0), cB, voffB); PG8_STAGE(PG8_SB(0, 1), cB + hstep, voffB); PG8_STAGE(PG8_SA(0, 0), cA, gc[0]); PG8_STAGE(PG8_SA(0, 1), cA + hstepA, gc[1]);
    if (wr == 1) PG8_BAR;
    PG8_WAIT_V(2); PG8_BAR;
    PG8_STAGE(PG8_SB(1, 0), cB + kstep, voffB); PG8_STAGE(PG8_SA(1, 0), cA + kstep, gc[0]); PG8_STAGE(PG8_SB(1, 1), cB + hstep + kstep, voffB);
    PG8_WAIT_V(6); PG8_BAR;
    for (;;) {
        const bool has_next = S.next(ui + 1, nxt);
        const char* nA = has_next ? S.a_ptr(nxt) : cA; const char* nB = has_next ? S.b_ptr(nxt) : cB;
        if (GATHER) { if (has_next) { PG8_GOFF(gn, nxt); } else {
#pragma unroll
            for (int h = 0; h < 2; ++h)
#pragma unroll
                for (int i = 0; i < 2; ++i) gn[h][i] = gc[h][i]; } }
        for (int t = 0; t < nt; t += 2) {
            const bool last = (t == nt - 2);
            const char* a1 = cA + (size_t)(t + 1) * kstep;
            const char* a2 = last ? nA : cA + (size_t)(t + 2) * kstep; const char* b2 = last ? nB : cB + (size_t)(t + 2) * kstep;
            const char* a3 = a2 + kstep; const char* b3 = b2 + kstep;
            unsigned gs[2][2];
#pragma unroll
            for (int h = 0; h < 2; ++h)
#pragma unroll
                for (int i = 0; i < 2; ++i) gs[h][i] = (GATHER && last) ? gn[h][i] : gc[h][i];
            PG8_LDB(B0, 0, 0); PG8_LDB(B1, 0, 1); PG8_SCHED; PG8_LDA(At, 0, 0); PG8_STAGE(PG8_SA(1, 1), a1 + hstepA, gc[1]);
            PG8_WAIT_V(8); PG8_WAIT_L(0); PG8_BAR; PG8_MMA(0, 0, At, B0); PG8_MMA(0, 1, At, B1); PG8_BAR; PG8_SCHED;
            PG8_LDA(At, 0, 1); PG8_STAGE(PG8_SB(0, 0), b2, voffB); PG8_STAGE(PG8_SB(0, 1), b2 + hstep, voffB); PG8_STAGE(PG8_SA(0, 0), a2, gs[0]);
            PG8_WAIT_V(8); PG8_WAIT_L(0); PG8_BAR; PG8_MMA(1, 0, At, B0); PG8_MMA(1, 1, At, B1); PG8_BAR; PG8_SCHED;
            PG8_LDB(B0, 1, 0); PG8_LDB(B1, 1, 1); PG8_SCHED; PG8_LDA(At, 1, 0); PG8_STAGE(PG8_SA(0, 1), a2 + hstepA, gs[1]);
            PG8_WAIT_V(8); PG8_WAIT_L(0); PG8_BAR; PG8_MMA(0, 0, At, B0); PG8_MMA(0, 1, At, B1); PG8_BAR; PG8_SCHED;
            PG8_LDA(At, 1, 1); PG8_STAGE(PG8_SB(1, 0), b3, voffB); PG8_STAGE(PG8_SB(1, 1), b3 + hstep, voffB); PG8_STAGE(PG8_SA(1, 0), a3, gs[0]);
            PG8_WAIT_V(8); PG8_WAIT_L(0); PG8_BAR; PG8_MMA(1, 0, At, B0); PG8_MMA(1, 1, At, B1); PG8_BAR; PG8_SCHED;
        }
        if constexpr (ALIGN_EPI) { if (wr == 0) PG8_BAR; }
        E(acc, cur, wr, wc, fr, fq);
        if (!has_next) break;
#pragma unroll
        for (int a = 0; a < 2; ++a)
#pragma unroll
            for (int b = 0; b < 2; ++b)
#pragma unroll
                for (int m = 0; m < 4; ++m)
#pragma unroll
                    for (int n = 0; n < 2; ++n) acc[a][b][m][n] = (f32x4){0.f, 0.f, 0.f, 0.f};
        cur = nxt; cA = nA; cB = nB; ++ui;
#pragma unroll
        for (int h = 0; h < 2; ++h)
#pragma unroll
            for (int i = 0; i < 2; ++i) gc[h][i] = gn[h][i];
        if constexpr (ALIGN_EPI) { if (wr == 1) PG8_BAR; }
    }
    PG8_WAIT_V(0);
    if constexpr (!ALIGN_EPI) { if (wr == 0) PG8_BAR; }
    PG8_BAR;
#undef PG8_SA
#undef PG8_SB
#undef PG8_STAGE
#undef PG8_LDA
#undef PG8_LDB
#undef PG8_MMA
#undef PG8_WAIT_V
#undef PG8_WAIT_L
#undef PG8_BAR
#undef PG8_SCHED
#undef PG8_GOFF
}
}

#define XB_TMO      128
#define XB_XCNT(j)  (256  + 64 * (j))
#define XB_XSUB(j)  (1280 + 64 * (j))
#define XB_XGEN(j)  (2304 + 64 * (j))
#define XB_TOP      3328
#define XB_TOPGEN   3392
#define XCD_BAR_WORDS 3456
#define XB_SPIN_CAP (1u << 18)

__device__ __forceinline__ unsigned xb_ld(unsigned* p)              { return __hip_atomic_load(p, __ATOMIC_RELAXED, __HIP_MEMORY_SCOPE_AGENT); }
__device__ __forceinline__ unsigned xb_add(unsigned* p, unsigned v) { return __hip_atomic_fetch_add(p, v, __ATOMIC_RELAXED, __HIP_MEMORY_SCOPE_AGENT); }
__device__ __forceinline__ unsigned xb_xcc_id() { return (unsigned)__builtin_amdgcn_s_getreg((3 << 11) | 20) & 0xFu; }
#define XB_SPIN(cond, bar) do { unsigned _sp = 0; while (cond) { __builtin_amdgcn_s_sleep(1); \
    if ((++_sp & 255u) == 0u) { if (xb_ld(&(bar)[XB_TMO])) break; if (_sp > XB_SPIN_CAP) { atomicAdd(&(bar)[XB_TMO], 1u); break; } } } } while (0)

struct XcdBarrier {
    unsigned* bar; unsigned x;
    volatile LAS unsigned* st;
};
__device__ __forceinline__ XcdBarrier xcd_barrier_post(unsigned* bar, volatile LAS unsigned* st) {
    XcdBarrier b; b.bar = bar; b.x = xb_xcc_id(); b.st = st;
    if (threadIdx.x == 0) (void)xb_add(&bar[XB_XCNT(b.x)], 1u);
    return b;
}
__device__ __forceinline__ void xcd_barrier_complete(unsigned* bar, unsigned x, unsigned& nloc, unsigned& nx) {
    const unsigned G = gridDim.x * gridDim.y * gridDim.z;
    unsigned sum, cnt, mine, sp = 0u;
    for (;;) {
        sum = 0u; cnt = 0u; mine = 0u;
#pragma unroll
        for (unsigned j = 0; j < 16; ++j) { const unsigned c = xb_ld(&bar[XB_XCNT(j)]); sum += c; cnt += (c > 0u) ? 1u : 0u; mine = (j == x) ? c : mine; }
        if (sum == G) break;
        __builtin_amdgcn_s_sleep(1);
        if ((++sp & 255u) == 0u) { if (xb_ld(&bar[XB_TMO])) break; if (sp > XB_SPIN_CAP) { atomicAdd(&bar[XB_TMO], 1u); break; } }
    }
    nloc = mine > 0u ? mine : 1u; nx = cnt > 0u ? cnt : 1u;
}
__device__ __forceinline__ void xcd_barrier(const XcdBarrier& b) {
    asm volatile("s_waitcnt vmcnt(0)" ::: "memory");
    __syncthreads();
    if (threadIdx.x == 0) {
        unsigned* bar = b.bar;
        __builtin_amdgcn_s_waitcnt(0);
        unsigned nloc = b.st[0], nx = b.st[1];
        if (nloc == 0u) { xcd_barrier_complete(bar, b.x, nloc, nx); b.st[0] = nloc; b.st[1] = nx; }
        const unsigned old = xb_add(&bar[XB_XSUB(b.x)], 1u);
        const unsigned gen = old / nloc;
        if (old + 1u == (gen + 1u) * nloc) {
            __builtin_amdgcn_fence(__ATOMIC_RELEASE, "agent");
            asm volatile("s_waitcnt vmcnt(0)" ::: "memory");
            const unsigned og = xb_add(&bar[XB_TOP], 1u);
            const unsigned tg = og / nx;
            if (og + 1u == (tg + 1u) * nx) xb_add(&bar[XB_TOPGEN], 1u);
            else XB_SPIN(xb_ld(&bar[XB_TOPGEN]) == tg, bar);
            __builtin_amdgcn_fence(__ATOMIC_ACQUIRE, "agent");
            xb_add(&bar[XB_XGEN(b.x)], 1u);
            asm volatile("s_waitcnt vmcnt(0)" ::: "memory");
        } else {
            XB_SPIN(xb_ld(&bar[XB_XGEN(b.x)]) == gen, bar);
            __builtin_amdgcn_fence(__ATOMIC_ACQUIRE, "agent");
            asm volatile("s_waitcnt vmcnt(0)" ::: "memory");
        }
    }
    __syncthreads();
}

#define LDS_WAIT() asm volatile("s_waitcnt lgkmcnt(0)" ::: "memory")
__device__ __forceinline__ void transpose_item(const float* __restrict__ W, int N, int k0, int n0, bf16_t* __restrict__ out, int ldo, LAS float* scr, int lane) {
#pragma unroll 8
    for (int i = 0; i < 32; ++i) { const int kk = 2 * i + (lane >> 5); scr[kk * 33 + (lane & 31)] = W[(size_t)(k0 + kk) * N + n0 + (lane & 31)]; }
    LDS_WAIT(); asm volatile("" ::: "memory");
    const int c = lane & 7;
#pragma unroll
    for (int j = 0; j < 4; ++j) { const int n = (lane >> 3) + 8 * j; const LAS float* s = scr + (8 * c) * 33 + n;
        u32x4 o; o.x = cvt_pk_bf16(s[0 * 33], s[1 * 33]); o.y = cvt_pk_bf16(s[2 * 33], s[3 * 33]); o.z = cvt_pk_bf16(s[4 * 33], s[5 * 33]); o.w = cvt_pk_bf16(s[6 * 33], s[7 * 33]);
        *(u32x4*)(out + (size_t)n * ldo + 8 * c) = o; }
    LDS_WAIT(); asm volatile("" ::: "memory");
}
__device__ __forceinline__ void cvt_rows(const float* __restrict__ src, bf16_t* __restrict__ dst, long nchunks, int gw, int NGW, int lane) {
    for (long c = gw; c < nchunks; c += NGW) {
        const float* s = src + c * 512 + lane * 8; const f32x4 a = *(const f32x4*)s, b = *(const f32x4*)(s + 4);
        u32x4 o; o.x = cvt_pk_bf16(a[0], a[1]); o.y = cvt_pk_bf16(a[2], a[3]); o.z = cvt_pk_bf16(b[0], b[1]); o.w = cvt_pk_bf16(b[2], b[3]);
        *(u32x4*)(dst + c * 512 + lane * 8) = o;
    }
}

struct Args { const float* in[22]; float* out; unsigned char* ws; int ph_lo, ph_hi, li, pad; };

struct LayerW { const float* wqkv; const float* wo; int Nq; int mixer; };
__device__ __forceinline__ const float* sel3(int mixer, const float* p0, const float* p1, const float* p2) {
    const uintptr_t m0 = (uintptr_t)0 - (uintptr_t)(mixer == 0), m1 = (uintptr_t)0 - (uintptr_t)(mixer == 1), m2 = (uintptr_t)0 - (uintptr_t)(mixer == 2);
    return (const float*)(((uintptr_t)p0 & m0) | ((uintptr_t)p1 & m1) | ((uintptr_t)p2 & m2));
}
__device__ __forceinline__ LayerW layer_weights(const float* qa, const float* oa, const float* qb, const float* ob, const float* qc, const float* oc, int layer) {
    LayerW w; w.mixer = layer % 3; const int j = layer / 3;
    w.Nq = (w.mixer == 1) ? 1536 : 3 * D;
    w.wqkv = sel3(w.mixer, qa + (size_t)j * D * 3 * D, qb + (size_t)j * D * 1536, qc + (size_t)j * D * 3 * D);
    w.wo = sel3(w.mixer, oa + (size_t)j * D * D, ob + (size_t)j * D * D, oc + (size_t)j * D * D);
    return w;
}

__device__ __forceinline__ void phase_cvt(const LayerW lw, const float* x_in, const float* p_in, const float* weg, const float* weu, const float* wed, const float* wpg, const float* wpp, unsigned char* ws, int layer, LAS unsigned char* lds, int gw, int NGW, int wave, int lane) {
    LAS float* scr = (LAS float*)(lds + wave * 8448);
    bf16_t* Wqkv_t = (bf16_t*)(ws + WS_WQKV); bf16_t* Wo_t = (bf16_t*)(ws + WS_WO); bf16_t* W1_t = (bf16_t*)(ws + WS_W1); bf16_t* W2_t = (bf16_t*)(ws + WS_W2);
    bf16_t* Wpg_t = (bf16_t*)(ws + WS_WPG); bf16_t* Wpp_t = (bf16_t*)(ws + WS_WPP);
    const int nqb = lw.Nq / 32, nq_items = 16 * nqb;
    const int total = nq_items + 512 + 3 * 8192 + 512 + 128;
    const float* wg = weg + (size_t)layer * NE * D * DE; const float* wu = weu + (size_t)layer * NE * D * DE; const float* wd = wed + (size_t)layer * NE * DE * D;
    for (int it = gw; it < total; it += NGW) {
        int r = it;
        if (r < nq_items) { const int kb = r / nqb, nb = r % nqb; transpose_item(lw.wqkv, lw.Nq, 64 * kb, 32 * nb, Wqkv_t + (size_t)(32 * nb) * D + 64 * kb, D, scr, lane); continue; } r -= nq_items;
        if (r < 512) { const int kb = r >> 5, nb = r & 31; transpose_item(lw.wo, D, 64 * kb, 32 * nb, Wo_t + (size_t)(32 * nb) * D + 64 * kb, D, scr, lane); continue; } r -= 512;
        if (r < 8192) { const int e = r >> 8, q = r & 255, kb = q >> 4, nb = q & 15, n0 = 32 * nb, row0 = 256 * (n0 >> 7) + (n0 & 127);
            transpose_item(wg + (size_t)e * D * DE, DE, 64 * kb, n0, W1_t + ((size_t)e * 1024 + row0) * D + 64 * kb, D, scr, lane); continue; } r -= 8192;
        if (r < 8192) { const int e = r >> 8, q = r & 255, kb = q >> 4, nb = q & 15, n0 = 32 * nb, row0 = 256 * (n0 >> 7) + 128 + (n0 & 127);
            transpose_item(wu + (size_t)e * D * DE, DE, 64 * kb, n0, W1_t + ((size_t)e * 1024 + row0) * D + 64 * kb, D, scr, lane); continue; } r -= 8192;
        if (r < 8192) { const int e = r >> 8, q = r & 255, kb = q >> 5, nb = q & 31;
            transpose_item(wd + (size_t)e * DE * D, D, 64 * kb, 32 * nb, W2_t + ((size_t)e * 1024 + 32 * nb) * DE + 64 * kb, DE, scr, lane); continue; } r -= 8192;
        if (r < 512) { const int kb = r >> 5, nb = r & 31; transpose_item(wpg + (size_t)layer * D * D, D, 64 * kb, 32 * nb, Wpg_t + (size_t)(32 * nb) * D + 64 * kb, D, scr, lane); continue; } r -= 512;
        { const int kb = r >> 5, nb = r & 31; transpose_item(wpp + (size_t)layer * PLE * D, D, 64 * kb, 32 * nb, Wpp_t + (size_t)(32 * nb) * PLE + 64 * kb, PLE, scr, lane); }
    }
    cvt_rows(p_in + (size_t)layer * M * PLE, (bf16_t*)(ws + WS_PB), (long)M * PLE / 512, gw, NGW, lane);
    if (layer == 0) cvt_rows(x_in, (bf16_t*)(ws + WS_XBA), (long)M * D / 512, gw, NGW, lane);
}

__device__ __forceinline__ void phase_kmean(const bf16_t* __restrict__ Kp, int ldk, float* __restrict__ kmean, LAS unsigned char* lds, int tid) {
    LAS float* red = (LAS float*)lds;
    for (int unit = blockIdx.x; unit < BATCH * 8; unit += gridDim.x) {
        const int b = unit >> 3, blk = unit & 7, cg = tid & 127, rg = tid >> 7;
        float s[8];
#pragma unroll
        for (int i = 0; i < 8; ++i) s[i] = 0.f;
        const bf16_t* p = Kp + (size_t)(b * SEQ + blk * 256 + rg * 64) * ldk + cg * 8;
        for (int r = 0; r < 64; ++r) { const u32x4 v = *(const u32x4*)(p + (size_t)r * ldk);
            s[0] += __uint_as_float(v.x << 16); s[1] += __uint_as_float(v.x & 0xffff0000u); s[2] += __uint_as_float(v.y << 16); s[3] += __uint_as_float(v.y & 0xffff0000u);
            s[4] += __uint_as_float(v.z << 16); s[5] += __uint_as_float(v.z & 0xffff0000u); s[6] += __uint_as_float(v.w << 16); s[7] += __uint_as_float(v.w & 0xffff0000u); }
        __syncthreads();
#pragma unroll
        for (int i = 0; i < 8; ++i) red[rg * 1024 + cg * 8 + i] = s[i];
        __syncthreads();
#pragma unroll
        for (int i = 0; i < 2; ++i) { const int c = tid * 2 + i; const float t = (red[c] + red[1024 + c]) + (red[2048 + c] + red[3072 + c]);
            kmean[(((size_t)(b * NH + (c >> 6)) * 8 + blk) * 64) + (c & 63)] = t * (1.f / 256.f); }
    }
    __syncthreads();
}

__device__ __forceinline__ void phase_ln1_route(const float* __restrict__ T, const float* __restrict__ g, const float* __restrict__ bb, float* __restrict__ X, bf16_t* __restrict__ xb,
                                                const float* __restrict__ wgrp, const float* __restrict__ bgrp, const float* __restrict__ wexp, const float* __restrict__ bexp,
                                                int* __restrict__ cnt, int* __restrict__ list, TokInfo* __restrict__ ti, LAS unsigned char* lds, int tid, int gw, int NGW, int lane) {
    LAS float* Wr = (LAS float*)lds;
    for (int idx = tid; idx < 1024 * 36; idx += NTHREADS) { const int k = idx / 36, c = idx - k * 36; const float v = c < 4 ? wgrp[k * 4 + c] : wexp[k * 32 + (c - 4)];
        const int rho = ((k >> 2) & 63) + 64 * (4 * (k >> 8) + (k & 3)); Wr[rho * 36 + c] = v; }
    __syncthreads();
    for (int row = gw; row < M; row += NGW) {
        f32x4 v[4]; float s = 0.f;
#pragma unroll
        for (int j = 0; j < 4; ++j) { v[j] = *(const f32x4*)(T + (size_t)row * D + (j * 64 + lane) * 4); s += (v[j][0] + v[j][1]) + (v[j][2] + v[j][3]); }
        const float mu = wave_sum(s) * (1.f / D); float q = 0.f;
#pragma unroll
        for (int j = 0; j < 4; ++j) { v[j] = v[j] - mu; q += (v[j][0] * v[j][0] + v[j][1] * v[j][1]) + (v[j][2] * v[j][2] + v[j][3] * v[j][3]); }
        const float rstd = 1.f / sqrtf(wave_sum(q) * (1.f / D) + LN_EPS);
#pragma unroll
        for (int j = 0; j < 4; ++j) { const int col = (j * 64 + lane) * 4; const f32x4 gg = *(const f32x4*)(g + col), b4 = *(const f32x4*)(bb + col);
            v[j] = v[j] * rstd * gg + b4;
            *(f32x4*)(X + (size_t)row * D + col) = v[j];
            u32x2 o; o.x = cvt_pk_bf16(v[j][0], v[j][1]); o.y = cvt_pk_bf16(v[j][2], v[j][3]); *(u32x2*)(xb + (size_t)row * D + col) = o; }
        float acc[36];
#pragma unroll
        for (int c = 0; c < 36; ++c) acc[c] = 0.f;
#pragma unroll
        for (int j = 0; j < 4; ++j)
#pragma unroll
            for (int u = 0; u < 4; ++u) { const float xs = v[j][u]; const LAS f32x4* wr = (const LAS f32x4*)(Wr + (lane + 64 * (4 * j + u)) * 36);
#pragma unroll
                for (int c4 = 0; c4 < 9; ++c4) { const f32x4 w = wr[c4]; acc[4 * c4] = fmaf(xs, w[0], acc[4 * c4]); acc[4 * c4 + 1] = fmaf(xs, w[1], acc[4 * c4 + 1]); acc[4 * c4 + 2] = fmaf(xs, w[2], acc[4 * c4 + 2]); acc[4 * c4 + 3] = fmaf(xs, w[3], acc[4 * c4 + 3]); }
                __builtin_amdgcn_sched_barrier(0); }
#pragma unroll
        for (int c = 0; c < 36; ++c) acc[c] = wave_sum(acc[c]);
        float gl[4];
#pragma unroll
        for (int c = 0; c < 4; ++c) gl[c] = acc[c] + bgrp[c];
        int gi = 0; float gm = gl[0];
#pragma unroll
        for (int c = 1; c < 4; ++c) if (gl[c] > gm) { gm = gl[c]; gi = c; }
        float gs = 0.f;
#pragma unroll
        for (int c = 0; c < 4; ++c) gs += __expf(gl[c] - gm);
        const float gp = 1.f / gs;
        float el[8];
#pragma unroll
        for (int c = 0; c < 8; ++c) { float t = acc[4 + c];
#pragma unroll
            for (int gq = 1; gq < 4; ++gq) t = (gi == gq) ? acc[4 + gq * 8 + c] : t;
            el[c] = t + bexp[gi * 8 + c]; }
        int i0 = 0; float m0 = el[0];
#pragma unroll
        for (int c = 1; c < 8; ++c) if (el[c] > m0) { m0 = el[c]; i0 = c; }
        int i1 = -1; float m1 = -INFINITY;
#pragma unroll
        for (int c = 0; c < 8; ++c) if (c != i0 && el[c] > m1) { m1 = el[c]; i1 = c; }
        const float p1 = __expf(m1 - m0);
        const float w0 = gp / (1.f + p1), w1 = gp * p1 / (1.f + p1);
        if (lane == 0) {
            const int e0 = gi * 8 + i0, e1 = gi * 8 + i1;
            const int q0 = atomicAdd(&cnt[e0], 1), q1 = atomicAdd(&cnt[e1], 1);
            list[(size_t)e0 * M + q0] = row; list[(size_t)e1 * M + q1] = row;
            TokInfo t; t.e0 = e0; t.p0 = q0; t.e1 = e1; t.p1 = q1; t.g0 = w0; t.g1 = w1; t.pad0 = 0; t.pad1 = 0;
            ti[row] = t;
        }
    }
    __syncthreads();
}

__device__ __forceinline__ void moe_tables(const int* __restrict__ cnt, LAS int* tbl, int tid) {
    __syncthreads();
    if (tid < 32) tbl[33 + tid] = cnt[tid];
    __syncthreads();
    if (tid == 0) { int acc = 0; for (int e = 0; e < 32; ++e) { tbl[e] = acc; acc += (tbl[33 + e] + 255) >> 8; } tbl[32] = acc; }
    __syncthreads();
}

__device__ __forceinline__ void phase_ln2(float* __restrict__ X, const bf16_t* __restrict__ Y, const TokInfo* __restrict__ ti, LAS const int* tbl, const float* __restrict__ g, const float* __restrict__ bb,
                                          bf16_t* __restrict__ xb, int gw, int NGW, int lane) {
    for (int row = gw; row < M; row += NGW) {
        const TokInfo t = ti[row];
        const bf16_t* y0 = Y + ((size_t)tbl[t.e0] * 256 + t.p0) * D; const bf16_t* y1 = Y + ((size_t)tbl[t.e1] * 256 + t.p1) * D;
        f32x4 v[4]; float s = 0.f;
#pragma unroll
        for (int j = 0; j < 4; ++j) { const int col = (j * 64 + lane) * 4; const f32x4 xv = *(const f32x4*)(X + (size_t)row * D + col);
            const u32x2 a = *(const u32x2*)(y0 + col), b = *(const u32x2*)(y1 + col);
            f32x4 ya, yb; ya[0] = __uint_as_float(a.x << 16); ya[1] = __uint_as_float(a.x & 0xffff0000u); ya[2] = __uint_as_float(a.y << 16); ya[3] = __uint_as_float(a.y & 0xffff0000u);
            yb[0] = __uint_as_float(b.x << 16); yb[1] = __uint_as_float(b.x & 0xffff0000u); yb[2] = __uint_as_float(b.y << 16); yb[3] = __uint_as_float(b.y & 0xffff0000u);
            v[j] = xv * ALPHA + (ya * t.g0 + yb * t.g1); s += (v[j][0] + v[j][1]) + (v[j][2] + v[j][3]); }
        const float mu = wave_sum(s) * (1.f / D); float q = 0.f;
#pragma unroll
        for (int j = 0; j < 4; ++j) { v[j] = v[j] - mu; q += (v[j][0] * v[j][0] + v[j][1] * v[j][1]) + (v[j][2] * v[j][2] + v[j][3] * v[j][3]); }
        const float rstd = 1.f / sqrtf(wave_sum(q) * (1.f / D) + LN_EPS);
#pragma unroll
        for (int j = 0; j < 4; ++j) { const int col = (j * 64 + lane) * 4; const f32x4 gg = *(const f32x4*)(g + col), b4 = *(const f32x4*)(bb + col);
            v[j] = v[j] * rstd * gg + b4;
            *(f32x4*)(X + (size_t)row * D + col) = v[j];
            u32x2 o; o.x = cvt_pk_bf16(v[j][0], v[j][1]); o.y = cvt_pk_bf16(v[j][2], v[j][3]); *(u32x2*)(xb + (size_t)row * D + col) = o; }
    }
}

template <int MODE>
__global__ __launch_bounds__(256) void k_attn(const bf16_t* __restrict__ Q, int ldq, const bf16_t* __restrict__ Kp, const bf16_t* __restrict__ Vp, int ldkv, int kvdiv,
                                               bf16_t* __restrict__ O, const float* __restrict__ kmean, const float* __restrict__ sinks, float qscale)
{
    __shared__ float Ks[64][64];
    __shared__ float Vs[64][64];
    const int c = blockIdx.x, h = blockIdx.y, b = blockIdx.z, tid = threadIdx.x;
    const int t = c * 256 + tid;
    const float slope = exp2f(-8.0f * (float)(h + 1) / 16.0f);
    float q[64], o[64];
    {
        const bf16_t* qp = Q + (size_t)(b * SEQ + t) * ldq + h * 64;
#pragma unroll
        for (int d = 0; d < 64; ++d) q[d] = bf2f(qp[d]) * qscale;
    }
#pragma unroll
    for (int d = 0; d < 64; ++d) o[d] = 0.f;
    unsigned selmask = 0;
    if (MODE == 0) {
        float g[8];
#pragma unroll
        for (int n = 0; n < 8; ++n) {
            float s = 0.f;
            if (n < c) {
                const float* km = kmean + (((size_t)(b * NH + h) * 8 + n) * 64);
#pragma unroll
                for (int d = 0; d < 64; ++d) s = fmaf(q[d], km[d], s);
            }
            g[n] = s;
        }
#pragma unroll
        for (int r = 0; r < 3; ++r) {
            float best = -INFINITY; int bi = -1;
#pragma unroll
            for (int n = 0; n < 8; ++n) { const bool cand = (n < c) && !((selmask >> n) & 1u) && (g[n] > best); if (cand) { best = g[n]; bi = n; } }
            if (bi >= 0) selmask |= 1u << bi;
        }
    }
    float m = -INFINITY, l = 0.f, after = 0.f;
    if (MODE == 1) { m = sinks[h]; l = 1.f; }
    int tile_lo, tile_hi;
    if (MODE == 0) { tile_lo = 0; tile_hi = 4 * c + 3; }
    else if (MODE == 1) { tile_lo = 4 * c - 2 < 0 ? 0 : 4 * c - 2; tile_hi = 4 * c + 3; }
    else { tile_lo = 0; tile_hi = 4 * c + 3; }
    const int kvh = h / kvdiv;
    for (int it = 0; it <= tile_hi - tile_lo; ++it) {
        const int tile = (MODE == 2) ? (tile_hi - it) : (tile_lo + it);
        __syncthreads();
#pragma unroll
        for (int i = 0; i < 4; ++i) {
            const int e = (i * 256 + tid) * 4, r = e >> 6, d = e & 63;
            const size_t off = (size_t)(b * SEQ + tile * 64 + r) * ldkv + kvh * 64 + d;
            const u32x2 kk = *(const u32x2*)(Kp + off), vv = *(const u32x2*)(Vp + off);
            Ks[r][d] = __uint_as_float(kk.x << 16); Ks[r][d + 1] = __uint_as_float(kk.x & 0xffff0000u); Ks[r][d + 2] = __uint_as_float(kk.y << 16); Ks[r][d + 3] = __uint_as_float(kk.y & 0xffff0000u);
            Vs[r][d] = __uint_as_float(vv.x << 16); Vs[r][d + 1] = __uint_as_float(vv.x & 0xffff0000u); Vs[r][d + 2] = __uint_as_float(vv.y << 16); Vs[r][d + 3] = __uint_as_float(vv.y & 0xffff0000u);
        }
        __syncthreads();
        for (int jj = 0; jj < 64; ++jj) {
            const int j = (MODE == 2) ? (63 - jj) : jj;
            const int s = tile * 64 + j;
            bool valid;
            if (MODE == 0) { const int n = tile >> 2; valid = (n == c) ? (s <= t) : (((selmask >> n) & 1u) != 0u); }
            else if (MODE == 1) { valid = (t - s >= 0) && (t - s < 128); }
            else { valid = s < t; }
            if (valid) {
                float dot = 0.f;
#pragma unroll
                for (int d = 0; d < 64; d += 4) { const float4 kk = *(const float4*)&Ks[j][d]; dot = fmaf(q[d], kk.x, dot); dot = fmaf(q[d + 1], kk.y, dot); dot = fmaf(q[d + 2], kk.z, dot); dot = fmaf(q[d + 3], kk.w, dot); }
                float p;
                if (MODE == 2) {
                    const float z = dot * 0.125f;
                    const float sp = fmaxf(z, 0.f) + log1pf(expf(-fabsf(z)));
                    p = expf(z - sp + after);
                    after -= sp;
                } else {
                    const float lg = dot * 0.125f - slope * (float)(t - s);
                    if (lg > m) { const float cs = expf(m - lg); l *= cs;
#pragma unroll
                        for (int d = 0; d < 64; ++d) o[d] *= cs;
                        m = lg; }
                    p = expf(lg - m); l += p;
                }
#pragma unroll
                for (int d = 0; d < 64; d += 4) { const float4 vv = *(const float4*)&Vs[j][d]; o[d] = fmaf(p, vv.x, o[d]); o[d + 1] = fmaf(p, vv.y, o[d + 1]); o[d + 2] = fmaf(p, vv.z, o[d + 2]); o[d + 3] = fmaf(p, vv.w, o[d + 3]); }
            }
        }
    }
    const float inv = (MODE == 2) ? 1.f : 1.f / l;
    bf16_t* op = O + (size_t)(b * SEQ + t) * D + h * 64;
#pragma unroll
    for (int d = 0; d < 64; d += 2) *(unsigned*)(op + d) = cvt_pk_bf16(o[d] * inv, o[d + 1] * inv);
}

struct KCtx { LAS unsigned char* lds; LAS int* tbl; unsigned char* ws; unsigned* ctl; int lo, hi, G, NGW, wave0; };
template <int layer>
__device__ __forceinline__ void run_layer(const Args& args, const KCtx& kc, const XcdBarrier& bar) {
    LAS unsigned char* lds = kc.lds; LAS int* tbl = kc.tbl; unsigned char* ws = kc.ws; unsigned* ctl = kc.ctl;
    const int lo = kc.lo, hi = kc.hi, G = kc.G, NGW = kc.NGW, wave0 = kc.wave0;
#define IN(k) (lo <= (k) && (k) < hi)
#define SEAM(k) do { if ((k) + 1 < hi) xcd_barrier(bar); } while (0)
    float* X = (float*)(ws + WS_X);
    bf16_t* QKV = (bf16_t*)(ws + WS_QKV); bf16_t* Ob = (bf16_t*)(ws + WS_O); float* T = (float*)(ws + WS_T);
    bf16_t* Hb = (bf16_t*)(ws + WS_H); bf16_t* Yb = (bf16_t*)(ws + WS_Y); bf16_t* PP = (bf16_t*)(ws + WS_PP); bf16_t* PB = (bf16_t*)(ws + WS_PB);
    TokInfo* ti = (TokInfo*)(ws + WS_TI); int* list = (int*)(ws + WS_LIST); float* kmean = (float*)(ws + WS_KMEAN);
    {

        const int base = layer * NPH;
#define OPQ() int lane_ = __builtin_amdgcn_mbcnt_hi(~0u, __builtin_amdgcn_mbcnt_lo(~0u, 0u)); asm volatile("" : "+v"(lane_)); const int lane = lane_, wave = wave0, tid = wave0 * 64 + lane, gw = blockIdx.x * NWAVES + wave
        if (base + NPH <= lo || base >= hi) return;
        const LayerW lw = layer_weights(args.in[2], args.in[3], args.in[4], args.in[5], args.in[7], args.in[8], layer);
        bf16_t* xb_cur = (bf16_t*)(ws + ((layer & 1) ? WS_XBB : WS_XBA));
        bf16_t* xb_oth = (bf16_t*)(ws + ((layer & 1) ? WS_XBA : WS_XBB));
        const float* xres = (layer == 0) ? args.in[0] : X;
        int* cnt = (int*)(ctl + CW_CNT) + layer * 32;

        if (IN(base + 0)) { OPQ(); phase_cvt(lw, args.in[0], args.in[1], args.in[17], args.in[18], args.in[19], args.in[20], args.in[21], ws, layer, lds, gw, NGW, wave, lane); SEAM(base + 0); }

        if (IN(base + 1)) {
            { pg8::DenseOrder S; S.init(xb_cur, (const bf16_t*)(ws + WS_WQKV), M, lw.Nq, D, G, (int)blockIdx.x);
              pg8::EpiStoreBf16 E{QKV, lw.Nq, 1.f, 0};
              pg8::gemm_phase<pg8::EpiStoreBf16, pg8::DenseOrder, true, false>(lds, D, S, E, wave0); }
            { pg8::DenseOrder S; S.init(PB, (const bf16_t*)(ws + WS_WPP), M, D, PLE, G, (int)blockIdx.x);
              pg8::EpiStoreBf16 E{PP, D, 1.f, 0};
              pg8::gemm_phase<pg8::EpiStoreBf16, pg8::DenseOrder, true, false>(lds, PLE, S, E, wave0); }
            SEAM(base + 1);
        }
        if (IN(base + 2)) { OPQ(); (void)lane; (void)gw; if (lw.mixer == 0) phase_kmean(QKV + D, lw.Nq, kmean, lds, tid); SEAM(base + 2); }
        if (IN(base + 3)) {   SEAM(base + 3); }
        if (IN(base + 4)) {
            pg8::DenseOrder S; S.init(Ob, (const bf16_t*)(ws + WS_WO), M, D, D, G, (int)blockIdx.x);
            pg8::EpiResF32 E{xres, T};
            pg8::gemm_phase<pg8::EpiResF32, pg8::DenseOrder, true, false>(lds, D, S, E, wave0);
            SEAM(base + 4);
        }
        if (IN(base + 5)) {
            OPQ(); phase_ln1_route(T, args.in[9] + layer * D, args.in[10] + layer * D, X, xb_oth, args.in[13] + (size_t)layer * D * 4, args.in[14] + layer * 4,
                            args.in[15] + (size_t)layer * D * 32, args.in[16] + layer * 32, cnt, list, ti, lds, tid, gw, NGW, lane);
            SEAM(base + 5);
        }
        if (IN(base + 6)) {
            { OPQ(); (void)lane; (void)gw; moe_tables(cnt, tbl, tid); }
            pg8::MoeOrder S; S.A = xb_oth; S.Bt = (const bf16_t*)(ws + WS_W1); S.K = D; S.strideB = (size_t)1024 * D; S.list = list; S.tbl = tbl; S.G = G; S.c = (int)blockIdx.x;
            pg8::EpiSwiglu E{Hb};
            pg8::gemm_phase<pg8::EpiSwiglu, pg8::MoeOrder, true, true>(lds, D, S, E, wave0);
            SEAM(base + 6);
        }
        if (IN(base + 7)) {
            { OPQ(); (void)lane; (void)gw; moe_tables(cnt, tbl, tid); }
            pg8::MoeOrder2 S; S.A = Hb; S.Bt = (const bf16_t*)(ws + WS_W2); S.K = DE; S.strideB = (size_t)1024 * DE; S.list = list; S.tbl = tbl; S.G = G; S.c = (int)blockIdx.x;
            pg8::EpiStoreBf16 E{Yb, D, 1.f, 0};
            pg8::gemm_phase<pg8::EpiStoreBf16, pg8::MoeOrder2, true, false>(lds, DE, S, E, wave0);
            SEAM(base + 7);
        }
        if (IN(base + 8)) {
            OPQ(); moe_tables(cnt, tbl, tid);
            phase_ln2(X, Yb, ti, tbl, args.in[11] + layer * D, args.in[12] + layer * D, xb_cur, gw, NGW, lane);
            SEAM(base + 8);
        }
        if (IN(base + 9)) {
            pg8::DenseOrder S; S.init(xb_cur, (const bf16_t*)(ws + WS_WPG), M, D, D, G, (int)blockIdx.x);
            pg8::EpiPle E{X, (layer == DEPTH - 1) ? args.out : X, PP, xb_oth};
            pg8::gemm_phase<pg8::EpiPle, pg8::DenseOrder, true, false>(lds, D, S, E, wave0);
            SEAM(base + 9);
        }
    }
#undef IN
#undef SEAM
#undef OPQ
}
__global__ void __launch_bounds__(NTHREADS, 2) mk_fwd(Args args) {
    extern __shared__ __attribute__((aligned(16))) unsigned char lds_raw[];
    LAS unsigned char* lds = (LAS unsigned char*)lds_raw;
    const int tid0 = threadIdx.x; const int wave0 = __builtin_amdgcn_readfirstlane(tid0 >> 6);
    volatile LAS unsigned* MISC = (volatile LAS unsigned*)(lds + MISC_OFF);
    for (int u = tid0; u < 256; u += NTHREADS) MISC[u] = 0u;
    __syncthreads();
    unsigned char* ws = args.ws;
    unsigned* ctl = (unsigned*)(ws + WS_CTL);
    XcdBarrier bar = xcd_barrier_post(ctl + CW_BAR + args.li * XCD_BAR_WORDS, MISC + MISC_BAR);
    KCtx kc; kc.lds = lds; kc.tbl = (LAS int*)(lds + MISC_OFF) + MISC_TBL; kc.ws = ws; kc.ctl = ctl; kc.lo = args.ph_lo; kc.hi = args.ph_hi; kc.G = gridDim.x; kc.NGW = gridDim.x * NWAVES; kc.wave0 = wave0;
    run_layer<0>(args, kc, bar); run_layer<1>(args, kc, bar); run_layer<2>(args, kc, bar); run_layer<3>(args, kc, bar);
}

extern "C" void kernel_launch(void* const* d_in, const int* in_sizes, int n_in, void* d_out, int out_size, void* d_ws, size_t ws_size, hipStream_t stream) {
    static int grid = 0;
    if (grid == 0) {
        if (n_in != 22 || ws_size < WS_END) { fprintf(stderr, "kernel_launch: unexpected inputs (n_in %d, ws %zu)\n", n_in, ws_size); grid = -1; return; }
        int dev = 0, cus = 0;
        if (hipGetDevice(&dev) != hipSuccess || hipDeviceGetAttribute(&cus, hipDeviceAttributeMultiprocessorCount, dev) != hipSuccess) { grid = -1; return; }
        if (hipFuncSetAttribute((const void*)mk_fwd, hipFuncAttributeMaxDynamicSharedMemorySize, LDS_BYTES) != hipSuccess) { fprintf(stderr, "kernel_launch: hipFuncSetAttribute failed\n"); grid = -1; return; }
        int per_cu = 0;
        if (hipOccupancyMaxActiveBlocksPerMultiprocessor(&per_cu, (const void*)mk_fwd, NTHREADS, LDS_BYTES) != hipSuccess || per_cu < 1) { fprintf(stderr, "kernel_launch: occupancy query says %d\n", per_cu); }
        (void)hipGetLastError();
        grid = cus;
    }
    if (grid < 0) return;
    (void)hipMemsetAsync((char*)d_ws + WS_CTL, 0, CTL_ZERO_BYTES, stream);
    Args a{};
    for (int i = 0; i < 22; ++i) a.in[i] = (const float*)d_in[i];
    a.out = (float*)d_out; a.ws = (unsigned char*)d_ws;
    unsigned char* ws = (unsigned char*)d_ws;
    int li = 0;
    for (int layer = 0; layer < DEPTH; ++layer) {
        const int mixer = layer % 3, j = layer / 3, base = layer * NPH;
        a.ph_lo = base; a.ph_hi = base + 3; a.li = li++;
        hipLaunchKernelGGL(mk_fwd, dim3(grid), dim3(NTHREADS), LDS_BYTES, stream, a);
        const bf16_t* QKV = (const bf16_t*)(ws + WS_QKV); bf16_t* Ob = (bf16_t*)(ws + WS_O); const float* kmean = (const float*)(ws + WS_KMEAN);
        if (mixer == 0) hipLaunchKernelGGL(k_attn<0>, dim3(8, 16, 16), dim3(256), 0, stream, QKV, 3 * D, QKV + D, QKV + 2 * D, 3 * D, 1, Ob, kmean, (const float*)nullptr, 1.f);
        else if (mixer == 1) hipLaunchKernelGGL(k_attn<1>, dim3(8, 16, 16), dim3(256), 0, stream, QKV, 1536, QKV + D, QKV + D + 256, 1536, 4, Ob, (const float*)nullptr, (const float*)d_in[6] + j * NH, 1.f);
        else hipLaunchKernelGGL(k_attn<2>, dim3(8, 16, 16), dim3(256), 0, stream, QKV, 3 * D, QKV + D, QKV + 2 * D, 3 * D, 1, Ob, (const float*)nullptr, (const float*)nullptr, 1.f);
        a.ph_lo = base + 4; a.ph_hi = base + NPH; a.li = li++;
        hipLaunchKernelGGL(mk_fwd, dim3(grid), dim3(NTHREADS), LDS_BYTES, stream, a);
    }
}
```

```cpp
#include <hip/hip_runtime.h>
#include <cstdint>
#include <cstdio>
#include <cmath>

#define LAS __attribute__((address_space(3)))
#define GAS __attribute__((address_space(1)))
typedef unsigned short bf16_t;
typedef short bf16x8 __attribute__((ext_vector_type(8)));
typedef float f32x4 __attribute__((ext_vector_type(4)));
typedef float f32x2 __attribute__((ext_vector_type(2)));
typedef unsigned u32x4 __attribute__((ext_vector_type(4)));
typedef unsigned u32x2 __attribute__((ext_vector_type(2)));

constexpr int D = 1024, BATCH = 16, SEQ = 2048, DEPTH = 4, M = BATCH * SEQ;
constexpr int HD = 64, NH = 16, NE = 32, DE = 512, PLE = 256;
constexpr int NSLOT = 65536 + 32 * 256;
constexpr float ALPHA = 1.681792830507429f;
constexpr float LN_EPS = 1e-5f;
constexpr float LOG2E = 1.4426950408889634f;
constexpr int NWAVES = 8, NTHREADS = 512;
constexpr int NPH = 10;
#ifndef ATTN_MFMA_MASK
#define ATTN_MFMA_MASK 7
#endif

constexpr size_t MiB = 1u << 20;
constexpr size_t WS_CTL = 0, CTL_ZERO_BYTES = 2 * MiB;
constexpr size_t WS_TI = 2 * MiB;
constexpr size_t WS_KMEAN = 3 * MiB;
constexpr size_t WS_LIST = 4 * MiB;
constexpr size_t WS_WQKV = 8 * MiB;
constexpr size_t WS_WO = 14 * MiB;
constexpr size_t WS_W1 = 16 * MiB;
constexpr size_t WS_W2 = 80 * MiB;
constexpr size_t WS_WPG = 112 * MiB;
constexpr size_t WS_WPP = 114 * MiB;
constexpr size_t WS_PB = 115 * MiB;
constexpr size_t WS_X = 132 * MiB;
constexpr size_t WS_XBA = 260 * MiB, WS_XBB = 324 * MiB;
constexpr size_t WS_R = 388 * MiB;
constexpr size_t WS_QKV = WS_R, WS_O = WS_R + 192 * MiB, WS_T = WS_R, WS_H = WS_R, WS_Y = WS_R + 72 * MiB;
constexpr size_t WS_PP = 644 * MiB;
constexpr size_t WS_END = 708 * MiB;
constexpr int CW_TMO = 0;
constexpr int CW_BAR = 4096;
constexpr int CW_CNT = 1024;

struct TokInfo { int e0, p0, e1, p1; float g0, g1; int pad0, pad1; };

constexpr int RING_BYTES = 131072;
constexpr int ROUTER_TBL_BYTES = 1024 * 36 * 4;
constexpr int MISC_OFF = 147456;
constexpr int MISC_BAR = 0;
constexpr int MISC_TBL = 16;
constexpr int LDS_BYTES = MISC_OFF + 1024;

__device__ __forceinline__ float bf2f(bf16_t v) { return __uint_as_float((unsigned)v << 16); }
__device__ __forceinline__ unsigned cvt_pk_bf16(float lo, float hi) { unsigned r; asm volatile("v_cvt_pk_bf16_f32 %0, %1, %2" : "=v"(r) : "v"(lo), "v"(hi)); return r; }
__device__ __forceinline__ float wave_sum(float v) {
#pragma unroll
    for (int o = 1; o < 64; o <<= 1) v += __shfl_xor(v, o);
    return v;
}

namespace pg8 {
#define PG8_LAS __attribute__((address_space(3)))
constexpr int BM = 256, BK = 64, HALF = 128, HTB = HALF * BK * 2  , STAGE_BYTES = 8 * HTB, NXCD = 8, WGM = 8;

__host__ __device__ __forceinline__ int lds_byte(int r, int c) { const int st = (r >> 4) * 2 + (c >> 5), rr = r & 15, cc = c & 31, ob = rr * 64 + cc * 2; return st * 1024 + (ob ^ (((ob >> 9) & 1) << 5)); }
__host__ __device__ __forceinline__ void stage_rc(int b, int& R, int& C) { const int st = b / 1024, sb = b % 1024, swz = sb ^ (((sb >> 9) & 1) << 5); R = (st >> 1) * 16 + swz / 64; C = (st & 1) * 32 + (swz % 64) / 2; }
__host__ __device__ __forceinline__ int perm32(int rho) { const int n = rho >> 4, i = rho & 15; return 8 * (i >> 2) + 4 * n + (i & 3); }

struct Unit { int pm, pn, e, lt; };

struct DenseOrder {
    const bf16_t* A; const bf16_t* Bt; int K;
    int nM, nN, nwg, G, c;
    __device__ __forceinline__ void init(const bf16_t* A_, const bf16_t* Bt_, int M_, int N_, int K_, int G_, int c_) { A = A_; Bt = Bt_; K = K_; nM = M_ / BM; nN = N_ / BM; nwg = nM * nN; G = G_; c = c_; }
    __device__ __forceinline__ bool next(int i, Unit& u) const {
        const long L = (long)i * G + c; if (L >= nwg) return false;
        int wgid = (int)L; { const int q = nwg / NXCD, r = nwg % NXCD, xcd = wgid % NXCD, off = wgid / NXCD; wgid = (xcd < r ? xcd * (q + 1) : r * (q + 1) + (xcd - r) * q) + off; }
        const int nig = WGM * nN, gid = wgid / nig, fm = gid * WGM, gsz = (nM - fm) < WGM ? (nM - fm) : WGM;
        u.pm = fm + ((wgid % nig) % gsz); u.pn = (wgid % nig) / gsz; u.e = 0; u.lt = 0; return true;
    }
    __device__ __forceinline__ const char* a_ptr(const Unit& u) const { return (const char*)A + (size_t)u.pm * BM * K * 2; }
    __device__ __forceinline__ const char* b_ptr(const Unit& u) const { return (const char*)Bt + (size_t)u.pn * BM * K * 2; }
    __device__ __forceinline__ int row_tok(const Unit&, int) const { return 0; }
};
struct MoeOrder {
    const bf16_t* A; const bf16_t* Bt; int K; size_t strideB;
    const int* list; PG8_LAS const int* tbl; int G, c;
    __device__ __forceinline__ bool next(int i, Unit& u) const {
        const int L = i * G + c, rt = L >> 2; if (rt >= tbl[32]) return false;
        u.pn = L & 3; int e = 0;
#pragma unroll
        for (int k = 1; k < 32; ++k) e += (rt >= tbl[k]) ? 1 : 0;
        u.e = e; u.lt = rt - tbl[e]; u.pm = rt; return true;
    }
    __device__ __forceinline__ const char* a_ptr(const Unit& u) const { return (const char*)A; }
    __device__ __forceinline__ const char* a_ptr_compact(const Unit& u) const { return (const char*)A + (size_t)u.pm * BM * K * 2; }
    __device__ __forceinline__ const char* b_ptr(const Unit& u) const { return (const char*)Bt + ((size_t)u.e * strideB + (size_t)u.pn * BM * K) * 2; }
    __device__ __forceinline__ int row_tok(const Unit& u, int r) const { const int pos = u.lt * BM + r; return pos < tbl[33 + u.e] ? list[(size_t)u.e * M + pos] : 0; }
};
struct MoeOrder2 : MoeOrder {
    __device__ __forceinline__ const char* a_ptr(const Unit& u) const { return a_ptr_compact(u); }
};

struct EpiStoreBf16 {
    static constexpr bool PERM = true;
    bf16_t* O; int ldc; float scale0; int scale_cols;
    __device__ __forceinline__ void operator()(const f32x4 (&acc)[2][2][4][2], const Unit& u, int wr, int wc, int fr, int fq) const {
        const int row0 = u.pm * BM + wr * 64 + fr, col0 = u.pn * BM + wc * 32 + 8 * fq;
        const float sc = (u.pn * BM < scale_cols) ? scale0 : 1.f;
#pragma unroll
        for (int ai = 0; ai < 2; ++ai)
#pragma unroll
            for (int m = 0; m < 4; ++m) { bf16_t* rowp = O + (size_t)(row0 + ai * HALF + m * 16) * ldc + col0;
#pragma unroll
                for (int bj = 0; bj < 2; ++bj) { const f32x4 v0 = acc[ai][bj][m][0] * sc, v1 = acc[ai][bj][m][1] * sc;
                    u32x4 w; w.x = cvt_pk_bf16(v0[0], v0[1]); w.y = cvt_pk_bf16(v0[2], v0[3]); w.z = cvt_pk_bf16(v1[0], v1[1]); w.w = cvt_pk_bf16(v1[2], v1[3]);
                    *(u32x4*)(rowp + bj * HALF) = w; } }
    }
};
struct EpiResF32 {
    static constexpr bool PERM = false;
    const float* xres; float* T;
    __device__ __forceinline__ void operator()(const f32x4 (&acc)[2][2][4][2], const Unit& u, int wr, int wc, int fr, int fq) const {
        const int row0 = u.pm * BM + wr * 64 + fr, col0 = u.pn * BM + wc * 32 + 4 * fq;
#pragma unroll
        for (int ai = 0; ai < 2; ++ai)
#pragma unroll
            for (int m = 0; m < 4; ++m) { const size_t off = (size_t)(row0 + ai * HALF + m * 16) * D + col0;
#pragma unroll
                for (int bj = 0; bj < 2; ++bj)
#pragma unroll
                    for (int n = 0; n < 2; ++n) { const f32x4 xr = *(const f32x4*)(xres + off + bj * HALF + n * 16); *(f32x4*)(T + off + bj * HALF + n * 16) = xr * ALPHA + acc[ai][bj][m][n]; } }
    }
};
__device__ __forceinline__ float silu_f(float g) { return g * __builtin_amdgcn_rcpf(1.f + __builtin_amdgcn_exp2f(-g * LOG2E)); }
__device__ __forceinline__ float sigmoid_f(float g) { return __builtin_amdgcn_rcpf(1.f + __builtin_amdgcn_exp2f(-g * LOG2E)); }
struct EpiSwiglu {
    static constexpr bool PERM = true;
    bf16_t* H;
    __device__ __forceinline__ void operator()(const f32x4 (&acc)[2][2][4][2], const Unit& u, int wr, int wc, int fr, int fq) const {
        const int row0 = u.pm * BM + wr * 64 + fr, col0 = u.pn * HALF + wc * 32 + 8 * fq;
#pragma unroll
        for (int ai = 0; ai < 2; ++ai)
#pragma unroll
            for (int m = 0; m < 4; ++m) { bf16_t* rowp = H + (size_t)(row0 + ai * HALF + m * 16) * DE + col0;
                const f32x4 g0 = acc[ai][0][m][0], g1 = acc[ai][0][m][1], u0 = acc[ai][1][m][0], u1 = acc[ai][1][m][1];
                u32x4 w; w.x = cvt_pk_bf16(silu_f(g0[0]) * u0[0], silu_f(g0[1]) * u0[1]); w.y = cvt_pk_bf16(silu_f(g0[2]) * u0[2], silu_f(g0[3]) * u0[3]);
                w.z = cvt_pk_bf16(silu_f(g1[0]) * u1[0], silu_f(g1[1]) * u1[1]); w.w = cvt_pk_bf16(silu_f(g1[2]) * u1[2], silu_f(g1[3]) * u1[3]);
                *(u32x4*)rowp = w; }
    }
};
struct EpiPle {
    static constexpr bool PERM = true;
    const float* xin; float* xout; const bf16_t* PP; bf16_t* xb;
    __device__ __forceinline__ void operator()(const f32x4 (&acc)[2][2][4][2], const Unit& u, int wr, int wc, int fr, int fq) const {
        const int row0 = u.pm * BM + wr * 64 + fr, col0 = u.pn * BM + wc * 32 + 8 * fq;
#pragma unroll
        for (int ai = 0; ai < 2; ++ai)
#pragma unroll
            for (int m = 0; m < 4; ++m) { const size_t off = (size_t)(row0 + ai * HALF + m * 16) * D + col0;
#pragma unroll
                for (int bj = 0; bj < 2; ++bj) { const size_t o2 = off + bj * HALF;
                    const f32x4 x0 = *(const f32x4*)(xin + o2), x1 = *(const f32x4*)(xin + o2 + 4); const u32x4 pp = *(const u32x4*)(PP + o2);
                    const f32x4 a0 = acc[ai][bj][m][0], a1 = acc[ai][bj][m][1];
                    f32x4 r0, r1;
                    r0[0] = x0[0] + sigmoid_f(a0[0]) * __uint_as_float(pp.x << 16); r0[1] = x0[1] + sigmoid_f(a0[1]) * __uint_as_float(pp.x & 0xffff0000u);
                    r0[2] = x0[2] + sigmoid_f(a0[2]) * __uint_as_float(pp.y << 16); r0[3] = x0[3] + sigmoid_f(a0[3]) * __uint_as_float(pp.y & 0xffff0000u);
                    r1[0] = x1[0] + sigmoid_f(a1[0]) * __uint_as_float(pp.z << 16); r1[1] = x1[1] + sigmoid_f(a1[1]) * __uint_as_float(pp.z & 0xffff0000u);
                    r1[2] = x1[2] + sigmoid_f(a1[2]) * __uint_as_float(pp.w << 16); r1[3] = x1[3] + sigmoid_f(a1[3]) * __uint_as_float(pp.w & 0xffff0000u);
                    *(f32x4*)(xout + o2) = r0; *(f32x4*)(xout + o2 + 4) = r1;
                    u32x4 w; w.x = cvt_pk_bf16(r0[0], r0[1]); w.y = cvt_pk_bf16(r0[2], r0[3]); w.z = cvt_pk_bf16(r1[0], r1[1]); w.w = cvt_pk_bf16(r1[2], r1[3]);
                    *(u32x4*)(xb + o2) = w; } }
    }
};

template <class Epi, class Sched, bool ALIGN_EPI, bool GATHER>
__device__ __forceinline__ void gemm_phase(PG8_LAS unsigned char* lds, const int K, const Sched& S, const Epi& E, const int wave0) {
    int tid_ = wave0 * 64 + (int)__builtin_amdgcn_mbcnt_hi(~0u, __builtin_amdgcn_mbcnt_lo(~0u, 0u)); asm volatile("" : "+v"(tid_));
    const int tid = tid_, wid = __builtin_amdgcn_readfirstlane(tid >> 6), lane = tid & 63, wr = wid >> 2, wc = wid & 3, fr = lane & 15, fq = lane >> 4;
    const int nt = K / BK;
    unsigned voffB[2]; int RA[2]; unsigned CA2[2];
#pragma unroll
    for (int i = 0; i < 2; ++i) { int R, C; stage_rc(tid * 16 + i * 8192, R, C); const int Rb = Epi::PERM ? ((R & ~31) + perm32(R & 31)) : R;
        RA[i] = R; CA2[i] = (unsigned)C * 2u; voffB[i] = (unsigned)(Rb * K + C) * 2u; }
    const size_t kstep = (size_t)(BK * 2);
    const size_t hstep = (size_t)HALF * K * 2;
    const size_t hstepA = GATHER ? (size_t)0 : hstep;
    const unsigned ldsw = (unsigned)wid * 1024u;
    const int aoff = lds_byte(wr * 64 + fr, fq * 8), boff = lds_byte(wc * 32 + fr, fq * 8);
#define PG8_SA(b, h) (((b) * 2 + (h)) * HTB)
#define PG8_SB(b, h) ((4 + (b) * 2 + (h)) * HTB)
#define PG8_STAGE(bufoff, gbase, voff) do { _Pragma("unroll") for (int _i = 0; _i < 2; ++_i) \
        __builtin_amdgcn_global_load_lds((const unsigned*)((const char*)(gbase) + (voff)[_i]), (PG8_LAS unsigned*)(lds + (bufoff) + ldsw + _i * 8192), 16, 0, 0); } while (0)
#define PG8_LDA(dst, b, h) do { _Pragma("unroll") for (int m = 0; m < 4; ++m) _Pragma("unroll") for (int k = 0; k < 2; ++k) dst[m][k] = *(const PG8_LAS bf16x8*)(lds + PG8_SA(b, h) + aoff + m * 2048 + k * 1024); } while (0)
#define PG8_LDB(dst, b, h) do { _Pragma("unroll") for (int n = 0; n < 2; ++n) _Pragma("unroll") for (int k = 0; k < 2; ++k) dst[n][k] = *(const PG8_LAS bf16x8*)(lds + PG8_SB(b, h) + boff + n * 2048 + k * 1024); } while (0)
#define PG8_MMA(ai, bj, At, Bt) do { __builtin_amdgcn_s_setprio(1); _Pragma("unroll") for (int m = 0; m < 4; ++m) _Pragma("unroll") for (int n = 0; n < 2; ++n) _Pragma("unroll") for (int k = 0; k < 2; ++k) \
        acc[ai][bj][m][n] = __builtin_amdgcn_mfma_f32_16x16x32_bf16(Bt[n][k], At[m][k], acc[ai][bj][m][n], 0, 0, 0); __builtin_amdgcn_s_setprio(0); } while (0)
#define PG8_WAIT_V(n) asm volatile("s_waitcnt vmcnt(" #n ")" ::: "memory")
#define PG8_WAIT_L(n) asm volatile("s_waitcnt lgkmcnt(" #n ")" ::: "memory")
#define PG8_BAR __builtin_amdgcn_s_barrier()
#define PG8_SCHED __builtin_amdgcn_sched_barrier(0)
#define PG8_GOFF(dst, u) do { _Pragma("unroll") for (int _h = 0; _h < 2; ++_h) _Pragma("unroll") for (int _i = 0; _i < 2; ++_i) \
        dst[_h][_i] = GATHER ? ((unsigned)S.row_tok(u, _h * HALF + RA[_i]) * (unsigned)(K * 2) + CA2[_i]) : ((unsigned)(RA[_i] * K) * 2u + CA2[_i]); } while (0)
    Unit cur, nxt; int ui = 0;
    if (!S.next(0, cur)) return;
    f32x4 acc[2][2][4][2];
#pragma unroll
    for (int a = 0; a < 2; ++a)
#pragma unroll
        for (int b = 0; b < 2; ++b)
#pragma unroll
            for (int m = 0; m < 4; ++m)
#pragma unroll
                for (int n = 0; n < 2; ++n) acc[a][b][m][n] = (f32x4){0.f, 0.f, 0.f, 0.f};
    bf16x8 At[4][2], B0[2][2], B1[2][2];
    unsigned gc[2][2], gn[2][2];
    PG8_GOFF(gc, cur);
    const char* cA = S.a_ptr(cur); const char* cB = S.b_ptr(cur);
    PG8_STAGE(PG8_SB(0, 0), cB, voffB); PG8_STAGE(PG8_SB(0, 1), cB + hstep, voffB); PG8_STAGE(PG8_SA(0, 0), cA, gc[0]); PG8_STAGE(PG8_SA(0, 1), cA + hstepA, gc[1]);
    if (wr == 1) PG8_BAR;
    PG8_WAIT_V(2); PG8_BAR;
    PG8_STAGE(PG8_SB(1, 0), cB + kstep, voffB); PG8_STAGE(PG8_SA(1, 0), cA + kstep, gc[0]); PG8_STAGE(PG8_SB(1, 1), cB + hstep + kstep, voffB);
    PG8_WAIT_V(6); PG8_BAR;
    for (;;) {
        const bool has_next = S.next(ui + 1, nxt);
        const char* nA = has_next ? S.a_ptr(nxt) : cA; const char* nB = has_next ? S.b_ptr(nxt) : cB;
        if (GATHER) { if (has_next) { PG8_GOFF(gn, nxt); } else {
#pragma unroll
            for (int h = 0; h < 2; ++h)
#pragma unroll
                for (int i = 0; i < 2; ++i) gn[h][i] = gc[h][i]; } }
        for (int t = 0; t < nt; t += 2) {
            const bool last = (t == nt - 2);
            const char* a1 = cA + (size_t)(t + 1) * kstep;
            const char* a2 = last ? nA : cA + (size_t)(t + 2) * kstep; const char* b2 = last ? nB : cB + (size_t)(t + 2) * kstep;
            const char* a3 = a2 + kstep; const char* b3 = b2 + kstep;
            unsigned gs[2][2];
#pragma unroll
            for (int h = 0; h < 2; ++h)
#pragma unroll
                for (int i = 0; i < 2; ++i) gs[h][i] = (GATHER && last) ? gn[h][i] : gc[h][i];
            PG8_LDB(B0, 0, 0); PG8_LDB(B1, 0, 1); PG8_SCHED; PG8_LDA(At, 0, 0); PG8_STAGE(PG8_SA(1, 1), a1 + hstepA, gc[1]);
            PG8_WAIT_V(8); PG8_WAIT_L(0); PG8_BAR; PG8_MMA(0, 0, At, B0); PG8_MMA(0, 1, At, B1); PG8_BAR; PG8_SCHED;
            PG8_LDA(At, 0, 1); PG8_STAGE(PG8_SB(0, 0), b2, voffB); PG8_STAGE(PG8_SB(0, 1), b2 + hstep, voffB); PG8_STAGE(PG8_SA(0, 0), a2, gs[0]);
            PG8_WAIT_V(8); PG8_WAIT_L(0); PG8_BAR; PG8_MMA(1, 0, At, B0); PG8_MMA(1, 1, At, B1); PG8_BAR; PG8_SCHED;
            PG8_LDB(B0, 1, 0); PG8_LDB(B1, 1, 1); PG8_SCHED; PG8_LDA(At, 1, 0); PG8_STAGE(PG8_SA(0, 1), a2 + hstepA, gs[1]);
            PG8_WAIT_V(8); PG8_WAIT_L(0); PG8_BAR; PG8_MMA(0, 0, At, B0); PG8_MMA(0, 1, At, B1); PG8_BAR; PG8_SCHED;
            PG8_LDA(At, 1, 1); PG8_STAGE(PG8_SB(1, 0), b3, voffB); PG8_STAGE(PG8_SB(1, 1), b3 + hstep, voffB); PG8_STAGE(PG8_SA(1, 0), a3, gs[0]);
            PG8_WAIT_V(8); PG8_WAIT_L(0); PG8_BAR; PG8_MMA(1, 0, At, B0); PG8_MMA(1, 1, At, B1); PG8_BAR; PG8_SCHED;
        }
        if constexpr (ALIGN_EPI) { if (wr == 0) PG8_BAR; }
        E(acc, cur, wr, wc, fr, fq);
        if (!has_next) break;
#pragma unroll
        for (int a = 0; a < 2; ++a)
#pragma unroll
            for (int b = 0; b < 2; ++b)
#pragma unroll
                for (int m = 0; m < 4; ++m)
#pragma unroll
                    for (int n = 0; n < 2; ++n) acc[a][b][m][n] = (f32x4){0.f, 0.f, 0.f, 0.f};
        cur = nxt; cA = nA; cB = nB; ++ui;
#pragma unroll
        for (int h = 0; h < 2; ++h)
#pragma unroll
            for (int i = 0; i < 2; ++i) gc[h][i] = gn[h][i];
        if constexpr (ALIGN_EPI) { if (wr == 1) PG8_BAR; }
    }
    PG8_WAIT_V(0);
    if constexpr (!ALIGN_EPI) { if (wr == 0) PG8_BAR; }
    PG8_BAR;
#undef PG8_SA
#undef PG8_SB
#undef PG8_STAGE
#undef PG8_LDA
#undef PG8_LDB
#undef PG8_MMA
#undef PG8_WAIT_V
#undef PG8_WAIT_L
#undef PG8_BAR
#undef PG8_SCHED
#undef PG8_GOFF
}
}

#define XB_TMO      128
#define XB_XCNT(j)  (256  + 64 * (j))
#define XB_XSUB(j)  (1280 + 64 * (j))
#define XB_XGEN(j)  (2304 + 64 * (j))
#define XB_TOP      3328
#define XB_TOPGEN   3392
#define XCD_BAR_WORDS 3456
#define XB_SPIN_CAP (1u << 18)

__device__ __forceinline__ unsigned xb_ld(unsigned* p)              { return __hip_atomic_load(p, __ATOMIC_RELAXED, __HIP_MEMORY_SCOPE_AGENT); }
__device__ __forceinline__ unsigned xb_add(unsigned* p, unsigned v) { return __hip_atomic_fetch_add(p, v, __ATOMIC_RELAXED, __HIP_MEMORY_SCOPE_AGENT); }
__device__ __forceinline__ unsigned xb_xcc_id() { return (unsigned)__builtin_amdgcn_s_getreg((3 << 11) | 20) & 0xFu; }
#define XB_SPIN(cond, bar) do { unsigned _sp = 0; while (cond) { __builtin_amdgcn_s_sleep(1); \
    if ((++_sp & 255u) == 0u) { if (xb_ld(&(bar)[XB_TMO])) break; if (_sp > XB_SPIN_CAP) { atomicAdd(&(bar)[XB_TMO], 1u); break; } } } } while (0)

struct XcdBarrier {
    unsigned* bar; unsigned x;
    volatile LAS unsigned* st;
};
__device__ __forceinline__ XcdBarrier xcd_barrier_post(unsigned* bar, volatile LAS unsigned* st) {
    XcdBarrier b; b.bar = bar; b.x = xb_xcc_id(); b.st = st;
    if (threadIdx.x == 0) (void)xb_add(&bar[XB_XCNT(b.x)], 1u);
    return b;
}
__device__ __forceinline__ void xcd_barrier_complete(unsigned* bar, unsigned x, unsigned& nloc, unsigned& nx) {
    const unsigned G = gridDim.x * gridDim.y * gridDim.z;
    unsigned sum, cnt, mine, sp = 0u;
    for (;;) {
        sum = 0u; cnt = 0u; mine = 0u;
#pragma unroll
        for (unsigned j = 0; j < 16; ++j) { const unsigned c = xb_ld(&bar[XB_XCNT(j)]); sum += c; cnt += (c > 0u) ? 1u : 0u; mine = (j == x) ? c : mine; }
        if (sum == G) break;
        __builtin_amdgcn_s_sleep(1);
        if ((++sp & 255u) == 0u) { if (xb_ld(&bar[XB_TMO])) break; if (sp > XB_SPIN_CAP) { atomicAdd(&bar[XB_TMO], 1u); break; } }
    }
    nloc = mine > 0u ? mine : 1u; nx = cnt > 0u ? cnt : 1u;
}
__device__ __forceinline__ void xcd_barrier(const XcdBarrier& b) {
    asm volatile("s_waitcnt vmcnt(0)" ::: "memory");
    __syncthreads();
    if (threadIdx.x == 0) {
        unsigned* bar = b.bar;
        __builtin_amdgcn_s_waitcnt(0);
        unsigned nloc = b.st[0], nx = b.st[1];
        if (nloc == 0u) { xcd_barrier_complete(bar, b.x, nloc, nx); b.st[0] = nloc; b.st[1] = nx; }
        const unsigned old = xb_add(&bar[XB_XSUB(b.x)], 1u);
        const unsigned gen = old / nloc;
        if (old + 1u == (gen + 1u) * nloc) {
            __builtin_amdgcn_fence(__ATOMIC_RELEASE, "agent");
            asm volatile("s_waitcnt vmcnt(0)" ::: "memory");
            const unsigned og = xb_add(&bar[XB_TOP], 1u);
            const unsigned tg = og / nx;
            if (og + 1u == (tg + 1u) * nx) xb_add(&bar[XB_TOPGEN], 1u);
            else XB_SPIN(xb_ld(&bar[XB_TOPGEN]) == tg, bar);
            __builtin_amdgcn_fence(__ATOMIC_ACQUIRE, "agent");
            xb_add(&bar[XB_XGEN(b.x)], 1u);
            asm volatile("s_waitcnt vmcnt(0)" ::: "memory");
        } else {
            XB_SPIN(xb_ld(&bar[XB_XGEN(b.x)]) == gen, bar);
            __builtin_amdgcn_fence(__ATOMIC_ACQUIRE, "agent");
            asm volatile("s_waitcnt vmcnt(0)" ::: "memory");
        }
    }
    __syncthreads();
}

#define LDS_WAIT() asm volatile("s_waitcnt lgkmcnt(0)" ::: "memory")
__device__ __forceinline__ void transpose_item(const float* __restrict__ W, int N, int k0, int n0, bf16_t* __restrict__ out, int ldo, LAS float* scr, int lane) {
#pragma unroll 8
    for (int i = 0; i < 32; ++i) { const int kk = 2 * i + (lane >> 5); scr[kk * 33 + (lane & 31)] = W[(size_t)(k0 + kk) * N + n0 + (lane & 31)]; }
    LDS_WAIT(); asm volatile("" ::: "memory");
    const int c = lane & 7;
#pragma unroll
    for (int j = 0; j < 4; ++j) { const int n = (lane >> 3) + 8 * j; const LAS float* s = scr + (8 * c) * 33 + n;
        u32x4 o; o.x = cvt_pk_bf16(s[0 * 33], s[1 * 33]); o.y = cvt_pk_bf16(s[2 * 33], s[3 * 33]); o.z = cvt_pk_bf16(s[4 * 33], s[5 * 33]); o.w = cvt_pk_bf16(s[6 * 33], s[7 * 33]);
        *(u32x4*)(out + (size_t)n * ldo + 8 * c) = o; }
    LDS_WAIT(); asm volatile("" ::: "memory");
}
__device__ __forceinline__ void cvt_rows(const float* __restrict__ src, bf16_t* __restrict__ dst, long nchunks, int gw, int NGW, int lane) {
    for (long c = gw; c < nchunks; c += NGW) {
        const float* s = src + c * 512 + lane * 8; const f32x4 a = *(const f32x4*)s, b = *(const f32x4*)(s + 4);
        u32x4 o; o.x = cvt_pk_bf16(a[0], a[1]); o.y = cvt_pk_bf16(a[2], a[3]); o.z = cvt_pk_bf16(b[0], b[1]); o.w = cvt_pk_bf16(b[2], b[3]);
        *(u32x4*)(dst + c * 512 + lane * 8) = o;
    }
}

struct Args { const float* in[22]; float* out; unsigned char* ws; int ph_lo, ph_hi, li, pad; };

struct LayerW { const float* wqkv; const float* wo; int Nq; int mixer; };
__device__ __forceinline__ const float* sel3(int mixer, const float* p0, const float* p1, const float* p2) {
    const uintptr_t m0 = (uintptr_t)0 - (uintptr_t)(mixer == 0), m1 = (uintptr_t)0 - (uintptr_t)(mixer == 1), m2 = (uintptr_t)0 - (uintptr_t)(mixer == 2);
    return (const float*)(((uintptr_t)p0 & m0) | ((uintptr_t)p1 & m1) | ((uintptr_t)p2 & m2));
}
__device__ __forceinline__ LayerW layer_weights(const float* qa, const float* oa, const float* qb, const float* ob, const float* qc, const float* oc, int layer) {
    LayerW w; w.mixer = layer % 3; const int j = layer / 3;
    w.Nq = (w.mixer == 1) ? 1536 : 3 * D;
    w.wqkv = sel3(w.mixer, qa + (size_t)j * D * 3 * D, qb + (size_t)j * D * 1536, qc + (size_t)j * D * 3 * D);
    w.wo = sel3(w.mixer, oa + (size_t)j * D * D, ob + (size_t)j * D * D, oc + (size_t)j * D * D);
    return w;
}

__device__ __forceinline__ void phase_cvt(const LayerW lw, const float* x_in, const float* p_in, const float* weg, const float* weu, const float* wed, const float* wpg, const float* wpp, unsigned char* ws, int layer, LAS unsigned char* lds, int gw, int NGW, int wave, int lane) {
    LAS float* scr = (LAS float*)(lds + wave * 8448);
    bf16_t* Wqkv_t = (bf16_t*)(ws + WS_WQKV); bf16_t* Wo_t = (bf16_t*)(ws + WS_WO); bf16_t* W1_t = (bf16_t*)(ws + WS_W1); bf16_t* W2_t = (bf16_t*)(ws + WS_W2);
    bf16_t* Wpg_t = (bf16_t*)(ws + WS_WPG); bf16_t* Wpp_t = (bf16_t*)(ws + WS_WPP);
    const int nqb = lw.Nq / 32, nq_items = 16 * nqb;
    const int total = nq_items + 512 + 3 * 8192 + 512 + 128;
    const float* wg = weg + (size_t)layer * NE * D * DE; const float* wu = weu + (size_t)layer * NE * D * DE; const float* wd = wed + (size_t)layer * NE * DE * D;
    for (int it = gw; it < total; it += NGW) {
        int r = it;
        if (r < nq_items) { const int kb = r / nqb, nb = r % nqb; transpose_item(lw.wqkv, lw.Nq, 64 * kb, 32 * nb, Wqkv_t + (size_t)(32 * nb) * D + 64 * kb, D, scr, lane); continue; } r -= nq_items;
        if (r < 512) { const int kb = r >> 5, nb = r & 31; transpose_item(lw.wo, D, 64 * kb, 32 * nb, Wo_t + (size_t)(32 * nb) * D + 64 * kb, D, scr, lane); continue; } r -= 512;
        if (r < 8192) { const int e = r >> 8, q = r & 255, kb = q >> 4, nb = q & 15, n0 = 32 * nb, row0 = 256 * (n0 >> 7) + (n0 & 127);
            transpose_item(wg + (size_t)e * D * DE, DE, 64 * kb, n0, W1_t + ((size_t)e * 1024 + row0) * D + 64 * kb, D, scr, lane); continue; } r -= 8192;
        if (r < 8192) { const int e = r >> 8, q = r & 255, kb = q >> 4, nb = q & 15, n0 = 32 * nb, row0 = 256 * (n0 >> 7) + 128 + (n0 & 127);
            transpose_item(wu + (size_t)e * D * DE, DE, 64 * kb, n0, W1_t + ((size_t)e * 1024 + row0) * D + 64 * kb, D, scr, lane); continue; } r -= 8192;
        if (r < 8192) { const int e = r >> 8, q = r & 255, kb = q >> 5, nb = q & 31;
            transpose_item(wd + (size_t)e * DE * D, D, 64 * kb, 32 * nb, W2_t + ((size_t)e * 1024 + 32 * nb) * DE + 64 * kb, DE, scr, lane); continue; } r -= 8192;
        if (r < 512) { const int kb = r >> 5, nb = r & 31; transpose_item(wpg + (size_t)layer * D * D, D, 64 * kb, 32 * nb, Wpg_t + (size_t)(32 * nb) * D + 64 * kb, D, scr, lane); continue; } r -= 512;
        { const int kb = r >> 5, nb = r & 31; transpose_item(wpp + (size_t)layer * PLE * D, D, 64 * kb, 32 * nb, Wpp_t + (size_t)(32 * nb) * PLE + 64 * kb, PLE, scr, lane); }
    }
    cvt_rows(p_in + (size_t)layer * M * PLE, (bf16_t*)(ws + WS_PB), (long)M * PLE / 512, gw, NGW, lane);
    if (layer == 0) cvt_rows(x_in, (bf16_t*)(ws + WS_XBA), (long)M * D / 512, gw, NGW, lane);
}

__device__ __forceinline__ void phase_kmean(const bf16_t* __restrict__ Kp, int ldk, float* __restrict__ kmean, LAS unsigned char* lds, int tid) {
    LAS float* red = (LAS float*)lds;
    for (int unit = blockIdx.x; unit < BATCH * 8; unit += gridDim.x) {
        const int b = unit >> 3, blk = unit & 7, cg = tid & 127, rg = tid >> 7;
        float s[8];
#pragma unroll
        for (int i = 0; i < 8; ++i) s[i] = 0.f;
        const bf16_t* p = Kp + (size_t)(b * SEQ + blk * 256 + rg * 64) * ldk + cg * 8;
        for (int r = 0; r < 64; ++r) { const u32x4 v = *(const u32x4*)(p + (size_t)r * ldk);
            s[0] += __uint_as_float(v.x << 16); s[1] += __uint_as_float(v.x & 0xffff0000u); s[2] += __uint_as_float(v.y << 16); s[3] += __uint_as_float(v.y & 0xffff0000u);
            s[4] += __uint_as_float(v.z << 16); s[5] += __uint_as_float(v.z & 0xffff0000u); s[6] += __uint_as_float(v.w << 16); s[7] += __uint_as_float(v.w & 0xffff0000u); }
        __syncthreads();
#pragma unroll
        for (int i = 0; i < 8; ++i) red[rg * 1024 + cg * 8 + i] = s[i];
        __syncthreads();
#pragma unroll
        for (int i = 0; i < 2; ++i) { const int c = tid * 2 + i; const float t = (red[c] + red[1024 + c]) + (red[2048 + c] + red[3072 + c]);
            kmean[(((size_t)(b * NH + (c >> 6)) * 8 + blk) * 64) + (c & 63)] = t * (1.f / 256.f); }
    }
    __syncthreads();
}

__device__ __forceinline__ void phase_ln1_route(const float* __restrict__ T, const float* __restrict__ g, const float* __restrict__ bb, float* __restrict__ X, bf16_t* __restrict__ xb,
                                                const float* __restrict__ wgrp, const float* __restrict__ bgrp, const float* __restrict__ wexp, const float* __restrict__ bexp,
                                                int* __restrict__ cnt, int* __restrict__ list, TokInfo* __restrict__ ti, LAS unsigned char* lds, int tid, int gw, int NGW, int lane) {
    LAS float* Wr = (LAS float*)lds;
    for (int idx = tid; idx < 1024 * 36; idx += NTHREADS) { const int k = idx / 36, c = idx - k * 36; const float v = c < 4 ? wgrp[k * 4 + c] : wexp[k * 32 + (c - 4)];
        const int rho = ((k >> 2) & 63) + 64 * (4 * (k >> 8) + (k & 3)); Wr[rho * 36 + c] = v; }
    __syncthreads();
    for (int row = gw; row < M; row += NGW) {
        f32x4 v[4]; float s = 0.f;
#pragma unroll
        for (int j = 0; j < 4; ++j) { v[j] = *(const f32x4*)(T + (size_t)row * D + (j * 64 + lane) * 4); s += (v[j][0] + v[j][1]) + (v[j][2] + v[j][3]); }
        const float mu = wave_sum(s) * (1.f / D); float q = 0.f;
#pragma unroll
        for (int j = 0; j < 4; ++j) { v[j] = v[j] - mu; q += (v[j][0] * v[j][0] + v[j][1] * v[j][1]) + (v[j][2] * v[j][2] + v[j][3] * v[j][3]); }
        const float rstd = 1.f / sqrtf(wave_sum(q) * (1.f / D) + LN_EPS);
#pragma unroll
        for (int j = 0; j < 4; ++j) { const int col = (j * 64 + lane) * 4; const f32x4 gg = *(const f32x4*)(g + col), b4 = *(const f32x4*)(bb + col);
            v[j] = v[j] * rstd * gg + b4;
            *(f32x4*)(X + (size_t)row * D + col) = v[j];
            u32x2 o; o.x = cvt_pk_bf16(v[j][0], v[j][1]); o.y = cvt_pk_bf16(v[j][2], v[j][3]); *(u32x2*)(xb + (size_t)row * D + col) = o; }
        float acc[36];
#pragma unroll
        for (int c = 0; c < 36; ++c) acc[c] = 0.f;
#pragma unroll
        for (int j = 0; j < 4; ++j)
#pragma unroll
            for (int u = 0; u < 4; ++u) { const float xs = v[j][u]; const LAS f32x4* wr = (const LAS f32x4*)(Wr + (lane + 64 * (4 * j + u)) * 36);
#pragma unroll
                for (int c4 = 0; c4 < 9; ++c4) { const f32x4 w = wr[c4]; acc[4 * c4] = fmaf(xs, w[0], acc[4 * c4]); acc[4 * c4 + 1] = fmaf(xs, w[1], acc[4 * c4 + 1]); acc[4 * c4 + 2] = fmaf(xs, w[2], acc[4 * c4 + 2]); acc[4 * c4 + 3] = fmaf(xs, w[3], acc[4 * c4 + 3]); }
                __builtin_amdgcn_sched_barrier(0); }
#pragma unroll
        for (int c = 0; c < 36; ++c) acc[c] = wave_sum(acc[c]);
        float gl[4];
#pragma unroll
        for (int c = 0; c < 4; ++c) gl[c] = acc[c] + bgrp[c];
        int gi = 0; float gm = gl[0];
#pragma unroll
        for (int c = 1; c < 4; ++c) if (gl[c] > gm) { gm = gl[c]; gi = c; }
        float gs = 0.f;
#pragma unroll
        for (int c = 0; c < 4; ++c) gs += __expf(gl[c] - gm);
        const float gp = 1.f / gs;
        float el[8];
#pragma unroll
        for (int c = 0; c < 8; ++c) { float t = acc[4 + c];
#pragma unroll
            for (int gq = 1; gq < 4; ++gq) t = (gi == gq) ? acc[4 + gq * 8 + c] : t;
            el[c] = t + bexp[gi * 8 + c]; }
        int i0 = 0; float m0 = el[0];
#pragma unroll
        for (int c = 1; c < 8; ++c) if (el[c] > m0) { m0 = el[c]; i0 = c; }
        int i1 = -1; float m1 = -INFINITY;
#pragma unroll
        for (int c = 0; c < 8; ++c) if (c != i0 && el[c] > m1) { m1 = el[c]; i1 = c; }
        const float p1 = __expf(m1 - m0);
        const float w0 = gp / (1.f + p1), w1 = gp * p1 / (1.f + p1);
        if (lane == 0) {
            const int e0 = gi * 8 + i0, e1 = gi * 8 + i1;
            const int q0 = atomicAdd(&cnt[e0], 1), q1 = atomicAdd(&cnt[e1], 1);
            list[(size_t)e0 * M + q0] = row; list[(size_t)e1 * M + q1] = row;
            TokInfo t; t.e0 = e0; t.p0 = q0; t.e1 = e1; t.p1 = q1; t.g0 = w0; t.g1 = w1; t.pad0 = 0; t.pad1 = 0;
            ti[row] = t;
        }
    }
    __syncthreads();
}

__device__ __forceinline__ void moe_tables(const int* __restrict__ cnt, LAS int* tbl, int tid) {
    __syncthreads();
    if (tid < 32) tbl[33 + tid] = cnt[tid];
    __syncthreads();
    if (tid == 0) { int acc = 0; for (int e = 0; e < 32; ++e) { tbl[e] = acc; acc += (tbl[33 + e] + 255) >> 8; } tbl[32] = acc; }
    __syncthreads();
}

__device__ __forceinline__ void phase_ln2(float* __restrict__ X, const bf16_t* __restrict__ Y, const TokInfo* __restrict__ ti, LAS const int* tbl, const float* __restrict__ g, const float* __restrict__ bb,
                                          bf16_t* __restrict__ xb, int gw, int NGW, int lane) {
    for (int row = gw; row < M; row += NGW) {
        const TokInfo t = ti[row];
        const bf16_t* y0 = Y + ((size_t)tbl[t.e0] * 256 + t.p0) * D; const bf16_t* y1 = Y + ((size_t)tbl[t.e1] * 256 + t.p1) * D;
        f32x4 v[4]; float s = 0.f;
#pragma unroll
        for (int j = 0; j < 4; ++j) { const int col = (j * 64 + lane) * 4; const f32x4 xv = *(const f32x4*)(X + (size_t)row * D + col);
            const u32x2 a = *(const u32x2*)(y0 + col), b = *(const u32x2*)(y1 + col);
            f32x4 ya, yb; ya[0] = __uint_as_float(a.x << 16); ya[1] = __uint_as_float(a.x & 0xffff0000u); ya[2] = __uint_as_float(a.y << 16); ya[3] = __uint_as_float(a.y & 0xffff0000u);
            yb[0] = __uint_as_float(b.x << 16); yb[1] = __uint_as_float(b.x & 0xffff0000u); yb[2] = __uint_as_float(b.y << 16); yb[3] = __uint_as_float(b.y & 0xffff0000u);
            v[j] = xv * ALPHA + (ya * t.g0 + yb * t.g1); s += (v[j][0] + v[j][1]) + (v[j][2] + v[j][3]); }
        const float mu = wave_sum(s) * (1.f / D); float q = 0.f;
#pragma unroll
        for (int j = 0; j < 4; ++j) { v[j] = v[j] - mu; q += (v[j][0] * v[j][0] + v[j][1] * v[j][1]) + (v[j][2] * v[j][2] + v[j][3] * v[j][3]); }
        const float rstd = 1.f / sqrtf(wave_sum(q) * (1.f / D) + LN_EPS);
#pragma unroll
        for (int j = 0; j < 4; ++j) { const int col = (j * 64 + lane) * 4; const f32x4 gg = *(const f32x4*)(g + col), b4 = *(const f32x4*)(bb + col);
            v[j] = v[j] * rstd * gg + b4;
            *(f32x4*)(X + (size_t)row * D + col) = v[j];
            u32x2 o; o.x = cvt_pk_bf16(v[j][0], v[j][1]); o.y = cvt_pk_bf16(v[j][2], v[j][3]); *(u32x2*)(xb + (size_t)row * D + col) = o; }
    }
}

template <int MODE>
__global__ __launch_bounds__(256) void k_attn(const bf16_t* __restrict__ Q, int ldq, const bf16_t* __restrict__ Kp, const bf16_t* __restrict__ Vp, int ldkv, int kvdiv,
                                               bf16_t* __restrict__ O, const float* __restrict__ kmean, const float* __restrict__ sinks, float qscale)
{
    __shared__ float Ks[64][64];
    __shared__ float Vs[64][64];
    const int c = blockIdx.x, h = blockIdx.y, b = blockIdx.z, tid = threadIdx.x;
    const int t = c * 256 + tid;
    const float slope = exp2f(-8.0f * (float)(h + 1) / 16.0f);
    float q[64], o[64];
    {
        const bf16_t* qp = Q + (size_t)(b * SEQ + t) * ldq + h * 64;
#pragma unroll
        for (int d = 0; d < 64; ++d) q[d] = bf2f(qp[d]) * qscale;
    }
#pragma unroll
    for (int d = 0; d < 64; ++d) o[d] = 0.f;
    unsigned selmask = 0;
    if (MODE == 0) {
        float g[8];
#pragma unroll
        for (int n = 0; n < 8; ++n) {
            float s = 0.f;
            if (n < c) {
                const float* km = kmean + (((size_t)(b * NH + h) * 8 + n) * 64);
#pragma unroll
                for (int d = 0; d < 64; ++d) s = fmaf(q[d], km[d], s);
            }
            g[n] = s;
        }
#pragma unroll
        for (int r = 0; r < 3; ++r) {
            float best = -INFINITY; int bi = -1;
#pragma unroll
            for (int n = 0; n < 8; ++n) { const bool cand = (n < c) && !((selmask >> n) & 1u) && (g[n] > best); if (cand) { best = g[n]; bi = n; } }
            if (bi >= 0) selmask |= 1u << bi;
        }
    }
    float m = -INFINITY, l = 0.f, after = 0.f;
    if (MODE == 1) { m = sinks[h]; l = 1.f; }
    int tile_lo, tile_hi;
    if (MODE == 0) { tile_lo = 0; tile_hi = 4 * c + 3; }
    else if (MODE == 1) { tile_lo = 4 * c - 2 < 0 ? 0 : 4 * c - 2; tile_hi = 4 * c + 3; }
    else { tile_lo = 0; tile_hi = 4 * c + 3; }
    const int kvh = h / kvdiv;
    for (int it = 0; it <= tile_hi - tile_lo; ++it) {
        const int tile = (MODE == 2) ? (tile_hi - it) : (tile_lo + it);
        __syncthreads();
#pragma unroll
        for (int i = 0; i < 4; ++i) {
            const int e = (i * 256 + tid) * 4, r = e >> 6, d = e & 63;
            const size_t off = (size_t)(b * SEQ + tile * 64 + r) * ldkv + kvh * 64 + d;
            const u32x2 kk = *(const u32x2*)(Kp + off), vv = *(const u32x2*)(Vp + off);
            Ks[r][d] = __uint_as_float(kk.x << 16); Ks[r][d + 1] = __uint_as_float(kk.x & 0xffff0000u); Ks[r][d + 2] = __uint_as_float(kk.y << 16); Ks[r][d + 3] = __uint_as_float(kk.y & 0xffff0000u);
            Vs[r][d] = __uint_as_float(vv.x << 16); Vs[r][d + 1] = __uint_as_float(vv.x & 0xffff0000u); Vs[r][d + 2] = __uint_as_float(vv.y << 16); Vs[r][d + 3] = __uint_as_float(vv.y & 0xffff0000u);
        }
        __syncthreads();
        for (int jj = 0; jj < 64; ++jj) {
            const int j = (MODE == 2) ? (63 - jj) : jj;
            const int s = tile * 64 + j;
            bool valid;
            if (MODE == 0) { const int n = tile >> 2; valid = (n == c) ? (s <= t) : (((selmask >> n) & 1u) != 0u); }
            else if (MODE == 1) { valid = (t - s >= 0) && (t - s < 128); }
            else { valid = s < t; }
            if (valid) {
                float dot = 0.f;
#pragma unroll
                for (int d = 0; d < 64; d += 4) { const float4 kk = *(const float4*)&Ks[j][d]; dot = fmaf(q[d], kk.x, dot); dot = fmaf(q[d + 1], kk.y, dot); dot = fmaf(q[d + 2], kk.z, dot); dot = fmaf(q[d + 3], kk.w, dot); }
                float p;
                if (MODE == 2) {
                    const float z = dot * 0.125f;
                    const float sp = fmaxf(z, 0.f) + log1pf(expf(-fabsf(z)));
                    p = expf(z - sp + after);
                    after -= sp;
                } else {
                    const float lg = dot * 0.125f - slope * (float)(t - s);
                    if (lg > m) { const float cs = expf(m - lg); l *= cs;
#pragma unroll
                        for (int d = 0; d < 64; ++d) o[d] *= cs;
                        m = lg; }
                    p = expf(lg - m); l += p;
                }
#pragma unroll
                for (int d = 0; d < 64; d += 4) { const float4 vv = *(const float4*)&Vs[j][d]; o[d] = fmaf(p, vv.x, o[d]); o[d + 1] = fmaf(p, vv.y, o[d + 1]); o[d + 2] = fmaf(p, vv.z, o[d + 2]); o[d + 3] = fmaf(p, vv.w, o[d + 3]); }
            }
        }
    }
    const float inv = (MODE == 2) ? 1.f : 1.f / l;
    bf16_t* op = O + (size_t)(b * SEQ + t) * D + h * 64;
#pragma unroll
    for (int d = 0; d < 64; d += 2) *(unsigned*)(op + d) = cvt_pk_bf16(o[d] * inv, o[d + 1] * inv);
}

namespace att {
typedef float f32x16 __attribute__((ext_vector_type(16)));
typedef _Float16 half8 __attribute__((ext_vector_type(8)));
typedef _Float16 half2v __attribute__((ext_vector_type(2)));
typedef short v4i16 __attribute__((ext_vector_type(4)));
constexpr int SLOTB = 8192, NSL = 3;
constexpr int L_K = 0, L_V = NSL * SLOTB, L_WS = 2 * NSL * SLOTB, L_OST = L_WS + 2048, L_KM = L_OST + 8 * 4096, L_FLAG = L_KM + 2048, L_END = L_FLAG + 64;
static_assert(L_END <= RING_BYTES, "attention LDS");

__device__ __forceinline__ int crow(int r, int hi) { return (r & 3) + 8 * (r >> 2) + 4 * hi; }
__device__ __forceinline__ float swap_max(float m) { auto rr = __builtin_amdgcn_permlane32_swap(__float_as_uint(m), __float_as_uint(m), false, false); return fmaxf(__uint_as_float(rr[0]), __uint_as_float(rr[1])); }
__device__ __forceinline__ float swap_sum(float m) { auto rr = __builtin_amdgcn_permlane32_swap(__float_as_uint(m), __float_as_uint(m), false, false); return __uint_as_float(rr[0]) + __uint_as_float(rr[1]); }
__device__ __forceinline__ v4i16 vtr(const LAS unsigned char* p) { return __builtin_amdgcn_ds_read_tr16_b64_v4i16((LAS v4i16*)p); }
__device__ __forceinline__ bf16x8 pack8(float a0, float a1, float a2, float a3, float a4, float a5, float a6, float a7) {
    u32x4 w; w.x = cvt_pk_bf16(a0, a1); w.y = cvt_pk_bf16(a2, a3); w.z = cvt_pk_bf16(a4, a5); w.w = cvt_pk_bf16(a6, a7); return __builtin_bit_cast(bf16x8, w); }
__device__ __forceinline__ half8 pack8h(float a0, float a1, float a2, float a3, float a4, float a5, float a6, float a7) {
    const half2v h0 = __builtin_convertvector((f32x2){a0, a1}, half2v), h1 = __builtin_convertvector((f32x2){a2, a3}, half2v), h2 = __builtin_convertvector((f32x2){a4, a5}, half2v), h3 = __builtin_convertvector((f32x2){a6, a7}, half2v);
    return (half8){h0[0], h0[1], h1[0], h1[1], h2[0], h2[1], h3[0], h3[1]}; }

template <int MODE>
__device__ __forceinline__ void attn_unit(const bf16_t* __restrict__ Qg, const bf16_t* __restrict__ Kg, const bf16_t* __restrict__ Vg, const int pitch, bf16_t* __restrict__ Og,
                                          const int c, const float slope2, const float sink2, const float* __restrict__ kmean_bh, LAS unsigned char* shm, const int wid, const int lane) {
    const int r32 = lane & 31, hi = lane >> 5;
    const int q0 = c * 256, qw0 = q0 + wid * 32, tq = qw0 + r32;
    const int tmax = 4 * c + 3, tmin = (MODE == 1) ? ((4 * c - 2 < 0) ? 0 : 4 * c - 2) : 0;
    const int NT = tmax - tmin + 1;
    LAS float* wsf = (LAS float*)(shm + L_WS) + wid * 64;
    const bf16_t* ksrc = Kg + (size_t)lane * pitch + wid * 8;
    const bf16_t* vsrc = Vg + (size_t)(16 * (wid & 3) + (lane >> 2)) * pitch + (wid >> 2) * 32 + (lane & 3) * 8;
#define ATT_PT(i) ((MODE == 2) ? (tmax - (i)) : (tmin + (i)))
#define ATT_DMA(i, slot) do { const size_t off_ = (size_t)ATT_PT(i) * 64 * pitch; \
        __builtin_amdgcn_global_load_lds((const unsigned*)(ksrc + off_), (LAS unsigned*)(shm + L_K + (slot) + wid * 1024), 16, 0, 0); \
        __builtin_amdgcn_global_load_lds((const unsigned*)(vsrc + off_), (LAS unsigned*)(shm + L_V + (slot) + wid * 1024), 16, 0, 0); } while (0)
    ATT_DMA(0, 0);
    if (NT > 1) ATT_DMA(1, SLOTB);
    bf16x8 qr[4];
    { const bf16_t* Qw = Qg + (size_t)tq * pitch;
#pragma unroll
      for (int d0 = 0; d0 < 4; ++d0) qr[d0] = *(const bf16x8*)(Qw + d0 * 16 + hi * 8); }
    unsigned selmask = 0u;
    if (MODE == 0) {
        LAS float* km = (LAS float*)(shm + L_KM);
        km[wid * 64 + lane] = kmean_bh[wid * 64 + lane];
        asm volatile("s_waitcnt vmcnt(0) lgkmcnt(0)" ::: "memory"); __builtin_amdgcn_s_barrier(); asm volatile("" ::: "memory");
        float g[8];
#pragma unroll
        for (int n = 0; n < 8; ++n) {
            float s = 0.f;
            if (n < c) {
#pragma unroll
                for (int d0 = 0; d0 < 4; ++d0) {
                    const f32x4 k0 = *(const LAS f32x4*)(km + n * 64 + 16 * d0 + 8 * hi), k1 = *(const LAS f32x4*)(km + n * 64 + 16 * d0 + 8 * hi + 4);
                    const u32x4 qq = __builtin_bit_cast(u32x4, qr[d0]);
                    s = fmaf(__uint_as_float(qq.x << 16), k0[0], s); s = fmaf(__uint_as_float(qq.x & 0xffff0000u), k0[1], s);
                    s = fmaf(__uint_as_float(qq.y << 16), k0[2], s); s = fmaf(__uint_as_float(qq.y & 0xffff0000u), k0[3], s);
                    s = fmaf(__uint_as_float(qq.z << 16), k1[0], s); s = fmaf(__uint_as_float(qq.z & 0xffff0000u), k1[1], s);
                    s = fmaf(__uint_as_float(qq.w << 16), k1[2], s); s = fmaf(__uint_as_float(qq.w & 0xffff0000u), k1[3], s);
                }
                s = swap_sum(s);
            }
            g[n] = s;
        }
#pragma unroll
        for (int rr = 0; rr < 3; ++rr) {
            float best = -INFINITY; int bi = -1;
#pragma unroll
            for (int n = 0; n < 8; ++n) { const bool cand = (n < c) && !((selmask >> n) & 1u) && (g[n] > best); if (cand) { best = g[n]; bi = n; } }
            if (bi >= 0) selmask |= 1u << bi;
        }
    }
    f32x16 o0 = {}, o1 = {};
    float mhat = (MODE == 1) ? sink2 : -1e30f;
    float l = (MODE == 1 && hi == 0) ? 1.f : 0.f;
    float carry = 0.f;
    half8 T0a, T0b, TONE;
    if (MODE == 2) {
#pragma unroll
        for (int j = 0; j < 8; ++j) { const int ks = (j & 3) + 8 * (j >> 2) + 4 * hi;
            T0a[j] = (ks > r32) ? (_Float16)1.0f : (_Float16)0.0f; T0b[j] = (16 + ks > r32) ? (_Float16)1.0f : (_Float16)0.0f; TONE[j] = (_Float16)1.0f; }
    }
    int slot = 0, slot2 = (2 % NSL) * SLOTB;
    for (int i = 0; i < NT; ++i) {
        if (i + 1 < NT) asm volatile("s_waitcnt vmcnt(2) lgkmcnt(0)" ::: "memory"); else asm volatile("s_waitcnt vmcnt(0) lgkmcnt(0)" ::: "memory");
        __builtin_amdgcn_s_barrier(); asm volatile("" ::: "memory");
        if (MODE == 2 && i > 0) {
            const LAS unsigned* fl = (const LAS unsigned*)(shm + L_FLAG) + ((i - 1) & 1) * 8;
            const u32x4 fa = *(const LAS u32x4*)fl, fb = *(const LAS u32x4*)(fl + 4);
            if ((fa.x & fa.y & fa.z & fa.w & fb.x & fb.y & fb.z & fb.w) != 0u) break;
        }
        if (i + 2 < NT) ATT_DMA(i + 2, slot2);
        const int pt = ATT_PT(i), kbase = pt * 64;
        bool need;
        if (MODE == 0) { const int n = pt >> 2; need = (n == c) ? (kbase <= qw0 + 31) : (__any((int)((selmask >> n) & 1u)) != 0); }
        else if (MODE == 1) need = (kbase <= qw0 + 31) && (kbase + 63 >= qw0 - 127);
        else need = (kbase < qw0 + 31);
        if (need) {
            f32x16 p0 = {}, p1 = {};
            { const LAS unsigned char* kb = shm + L_K + slot + hi * 1024 + r32 * 16;
#pragma unroll
              for (int d0 = 0; d0 < 4; ++d0) { const bf16x8 b0 = *(const LAS bf16x8*)(kb + d0 * 2048), b1 = *(const LAS bf16x8*)(kb + d0 * 2048 + 512);
                  p0 = __builtin_amdgcn_mfma_f32_32x32x16_bf16(b0, qr[d0], p0, 0, 0, 0); p1 = __builtin_amdgcn_mfma_f32_32x32x16_bf16(b1, qr[d0], p1, 0, 0, 0); } }
            bf16x8 pw0, pw1, pw2, pw3;
            if (MODE != 2) {
                const float at = slope2 * (float)(kbase + 4 * hi - tq), s32 = 32.f * slope2;
                const int dq = tq - kbase - 4 * hi;
                const bool selb = (MODE == 0) ? (((selmask >> (pt >> 2)) & 1u) != 0u) : true;
                const bool own = (MODE == 0) ? ((pt >> 2) == c) : true;
#pragma unroll
                for (int r = 0; r < 16; ++r) { const int kr = (r & 3) + 8 * (r >> 2); const float bb = fmaf(slope2, (float)kr, at);
                    const int d0_ = dq - kr, d1_ = d0_ - 32;
                    bool v0, v1;
                    if (MODE == 0) { v0 = own ? (d0_ >= 0) : selb; v1 = own ? (d1_ >= 0) : selb; }
                    else { v0 = (d0_ >= 0) && (d0_ < 128); v1 = (d1_ >= 0) && (d1_ < 128); }
                    p0[r] = v0 ? (p0[r] + bb) : -INFINITY; p1[r] = v1 ? (p1[r] + (bb + s32)) : -INFINITY; }
                float rm = fmaxf(p0[0], p1[0]);
#pragma unroll
                for (int r = 1; r < 16; ++r) rm = fmaxf(rm, fmaxf(p0[r], p1[r]));
                rm = swap_max(rm);
                if (__any((int)(rm > mhat + 8.f))) {
                    const float mnew = fmaxf(mhat, rm), f = __builtin_amdgcn_exp2f(mhat - mnew);
                    mhat = mnew; l *= f;
                    if (hi == 0) wsf[r32] = f;
                    asm volatile("s_waitcnt lgkmcnt(0)" ::: "memory");
#pragma unroll
                    for (int r = 0; r < 16; ++r) { const float fr_ = wsf[crow(r, hi)]; o0[r] *= fr_; o1[r] *= fr_; }
                }
                float sacc = 0.f;
#pragma unroll
                for (int r = 0; r < 16; ++r) { p0[r] = __builtin_amdgcn_exp2f(p0[r] - mhat); p1[r] = __builtin_amdgcn_exp2f(p1[r] - mhat); sacc += p0[r] + p1[r]; }
                l += sacc;
            } else {
                f32x16 lk0, lk1;
                const int dq = tq - kbase - 4 * hi;
                float tsum = 0.f;
#pragma unroll
                for (int r = 0; r < 16; ++r) { const int kr = (r & 3) + 8 * (r >> 2);
                    const bool v0 = (dq - kr) > 0, v1 = (dq - kr - 32) > 0;
                    { const float z = p0[r], e = __builtin_amdgcn_exp2f(-fabsf(z)), sp = fmaxf(z, 0.f) + __builtin_amdgcn_logf(1.f + e); lk0[r] = v0 ? -sp : 0.f; }
                    { const float z = p1[r], e = __builtin_amdgcn_exp2f(-fabsf(z)), sp = fmaxf(z, 0.f) + __builtin_amdgcn_logf(1.f + e); lk1[r] = v1 ? -sp : 0.f; }
                    tsum += lk0[r] + lk1[r]; }
                tsum = swap_sum(tsum);
                const half8 L0 = pack8h(lk0[0], lk0[1], lk0[2], lk0[3], lk0[4], lk0[5], lk0[6], lk0[7]), L1 = pack8h(lk0[8], lk0[9], lk0[10], lk0[11], lk0[12], lk0[13], lk0[14], lk0[15]);
                const half8 L2 = pack8h(lk1[0], lk1[1], lk1[2], lk1[3], lk1[4], lk1[5], lk1[6], lk1[7]), L3 = pack8h(lk1[8], lk1[9], lk1[10], lk1[11], lk1[12], lk1[13], lk1[14], lk1[15]);
                f32x16 c0 = {}, c1 = {};
                c0 = __builtin_amdgcn_mfma_f32_32x32x16_f16(T0a, L0, c0, 0, 0, 0); c0 = __builtin_amdgcn_mfma_f32_32x32x16_f16(T0b, L1, c0, 0, 0, 0);
                c0 = __builtin_amdgcn_mfma_f32_32x32x16_f16(TONE, L2, c0, 0, 0, 0); c0 = __builtin_amdgcn_mfma_f32_32x32x16_f16(TONE, L3, c0, 0, 0, 0);
                c1 = __builtin_amdgcn_mfma_f32_32x32x16_f16(T0a, L2, c1, 0, 0, 0); c1 = __builtin_amdgcn_mfma_f32_32x32x16_f16(T0b, L3, c1, 0, 0, 0);
#pragma unroll
                for (int r = 0; r < 16; ++r) { const int kr = (r & 3) + 8 * (r >> 2);
                    const bool v0 = (dq - kr) > 0, v1 = (dq - kr - 32) > 0;
                    p0[r] = v0 ? __builtin_amdgcn_exp2f(p0[r] + lk0[r] + (carry + c0[r])) : 0.f;
                    p1[r] = v1 ? __builtin_amdgcn_exp2f(p1[r] + lk1[r] + (carry + c1[r])) : 0.f; }
                carry += tsum;
            }
            pw0 = pack8(p0[0], p0[1], p0[2], p0[3], p0[4], p0[5], p0[6], p0[7]); pw1 = pack8(p0[8], p0[9], p0[10], p0[11], p0[12], p0[13], p0[14], p0[15]);
            pw2 = pack8(p1[0], p1[1], p1[2], p1[3], p1[4], p1[5], p1[6], p1[7]); pw3 = pack8(p1[8], p1[9], p1[10], p1[11], p1[12], p1[13], p1[14], p1[15]);
            { const LAS unsigned char* vp = shm + L_V + slot + ((lane >> 4) & 1) * 32 + (lane & 3) * 8 + (4 * hi + ((lane & 15) >> 2)) * 64;
#define ATT_PV(od, d0, ks, pw) do { const v4i16 lo_ = vtr(vp + (d0) * 4096 + (ks) * 1024), hh_ = vtr(vp + (d0) * 4096 + (ks) * 1024 + 512); \
                  const bf16x8 vf_ = (bf16x8){lo_[0], lo_[1], lo_[2], lo_[3], hh_[0], hh_[1], hh_[2], hh_[3]}; od = __builtin_amdgcn_mfma_f32_32x32x16_bf16(pw, vf_, od, 0, 0, 0); } while (0)
              ATT_PV(o0, 0, 0, pw0); ATT_PV(o1, 1, 0, pw0); ATT_PV(o0, 0, 1, pw1); ATT_PV(o1, 1, 1, pw1);
              ATT_PV(o0, 0, 2, pw2); ATT_PV(o1, 1, 2, pw2); ATT_PV(o0, 0, 3, pw3); ATT_PV(o1, 1, 3, pw3);
#undef ATT_PV
            }
        }
        if (MODE == 2) { const bool done = __all((int)(carry < -150.f)) != 0; if (lane == 0) ((LAS unsigned*)(shm + L_FLAG))[(i & 1) * 8 + wid] = done ? 1u : 0u; }
        slot = (slot == (NSL - 1) * SLOTB) ? 0 : slot + SLOTB; slot2 = (slot2 == (NSL - 1) * SLOTB) ? 0 : slot2 + SLOTB;
    }
    if (MODE != 2) l = swap_sum(l);
    if (hi == 0) wsf[r32] = (MODE == 2) ? 1.f : __builtin_amdgcn_rcpf(l);
    asm volatile("s_waitcnt lgkmcnt(0)" ::: "memory");
    { LAS bf16_t* stg = (LAS bf16_t*)(shm + L_OST) + wid * 2048;
#pragma unroll
      for (int r = 0; r < 16; ++r) { const int orow = crow(r, hi); const float rl = wsf[orow];
          stg[orow * 64 + r32] = (bf16_t)(cvt_pk_bf16(o0[r] * rl, 0.f) & 0xffffu); stg[orow * 64 + 32 + r32] = (bf16_t)(cvt_pk_bf16(o1[r] * rl, 0.f) & 0xffffu); }
      asm volatile("s_waitcnt lgkmcnt(0)" ::: "memory");
      bf16_t* Ow = Og + (size_t)qw0 * D;
#pragma unroll
      for (int i = 0; i < 4; ++i) { const int row = i * 8 + (lane >> 3), ch = lane & 7; const u32x4 v = *(const LAS u32x4*)(stg + row * 64 + ch * 8); *(u32x4*)(Ow + (size_t)row * D + ch * 8) = v; } }
    asm volatile("s_waitcnt vmcnt(0) lgkmcnt(0)" ::: "memory"); __builtin_amdgcn_s_barrier(); asm volatile("" ::: "memory");
#undef ATT_PT
#undef ATT_DMA
}

template <int MODE>
__device__ __forceinline__ void attn_phase(const bf16_t* __restrict__ QKV, const int pitch, const int kcol, const int vcol, const int kvdiv, bf16_t* __restrict__ O,
                                           const float* __restrict__ kmean, const float* __restrict__ sinks, LAS unsigned char* shm, const int wave0) {
    int lane_ = (int)__builtin_amdgcn_mbcnt_hi(~0u, __builtin_amdgcn_mbcnt_lo(~0u, 0u)); asm volatile("" : "+v"(lane_));
    const int lane = lane_, wid = wave0;
    for (int u = blockIdx.x; u < BATCH * NH * 8; u += gridDim.x) {
        const int bh = u & 255, c = u >> 8, b = bh >> 4, h = bh & 15;
        const float slope2 = exp2f(-0.5f * (float)(h + 1)) * LOG2E;
        const float sink2 = (MODE == 1) ? sinks[h] * LOG2E : 0.f;
        const bf16_t* base = QKV + (size_t)b * SEQ * pitch;
        attn_unit<MODE>(base + h * 64, base + kcol + (h / kvdiv) * 64, base + vcol + (h / kvdiv) * 64, pitch, O + (size_t)b * SEQ * D + h * 64, c, slope2, sink2,
                        (MODE == 0) ? (kmean + (size_t)bh * 512) : kmean, shm, wid, lane);
    }
}
}

struct KCtx { LAS unsigned char* lds; LAS int* tbl; unsigned char* ws; unsigned* ctl; int lo, hi, G, NGW, wave0; };
template <int layer>
__device__ __forceinline__ void run_layer(const Args& args, const KCtx& kc, const XcdBarrier& bar) {
    LAS unsigned char* lds = kc.lds; LAS int* tbl = kc.tbl; unsigned char* ws = kc.ws; unsigned* ctl = kc.ctl;
    const int lo = kc.lo, hi = kc.hi, G = kc.G, NGW = kc.NGW, wave0 = kc.wave0;
#define IN(k) (lo <= (k) && (k) < hi)
#define SEAM(k) do { if ((k) + 1 < hi) xcd_barrier(bar); } while (0)
    float* X = (float*)(ws + WS_X);
    bf16_t* QKV = (bf16_t*)(ws + WS_QKV); bf16_t* Ob = (bf16_t*)(ws + WS_O); float* T = (float*)(ws + WS_T);
    bf16_t* Hb = (bf16_t*)(ws + WS_H); bf16_t* Yb = (bf16_t*)(ws + WS_Y); bf16_t* PP = (bf16_t*)(ws + WS_PP); bf16_t* PB = (bf16_t*)(ws + WS_PB);
    TokInfo* ti = (TokInfo*)(ws + WS_TI); int* list = (int*)(ws + WS_LIST); float* kmean = (float*)(ws + WS_KMEAN);
    {

        const int base = layer * NPH;
#define OPQ() int lane_ = __builtin_amdgcn_mbcnt_hi(~0u, __builtin_amdgcn_mbcnt_lo(~0u, 0u)); asm volatile("" : "+v"(lane_)); const int lane = lane_, wave = wave0, tid = wave0 * 64 + lane, gw = blockIdx.x * NWAVES + wave
        if (base + NPH <= lo || base >= hi) return;
        const LayerW lw = layer_weights(args.in[2], args.in[3], args.in[4], args.in[5], args.in[7], args.in[8], layer);
        bf16_t* xb_cur = (bf16_t*)(ws + ((layer & 1) ? WS_XBB : WS_XBA));
        bf16_t* xb_oth = (bf16_t*)(ws + ((layer & 1) ? WS_XBA : WS_XBB));
        const float* xres = (layer == 0) ? args.in[0] : X;
        int* cnt = (int*)(ctl + CW_CNT) + layer * 32;

        if (IN(base + 0)) { OPQ(); phase_cvt(lw, args.in[0], args.in[1], args.in[17], args.in[18], args.in[19], args.in[20], args.in[21], ws, layer, lds, gw, NGW, wave, lane); SEAM(base + 0); }

        if (IN(base + 1)) {
            { pg8::DenseOrder S; S.init(xb_cur, (const bf16_t*)(ws + WS_WQKV), M, lw.Nq, D, G, (int)blockIdx.x);
              pg8::EpiStoreBf16 E{QKV, lw.Nq, 0.125f * LOG2E, D};
              pg8::gemm_phase<pg8::EpiStoreBf16, pg8::DenseOrder, true, false>(lds, D, S, E, wave0); }
            { pg8::DenseOrder S; S.init(PB, (const bf16_t*)(ws + WS_WPP), M, D, PLE, G, (int)blockIdx.x);
              pg8::EpiStoreBf16 E{PP, D, 1.f, 0};
              pg8::gemm_phase<pg8::EpiStoreBf16, pg8::DenseOrder, true, false>(lds, PLE, S, E, wave0); }
            SEAM(base + 1);
        }
        if (IN(base + 2)) { OPQ(); (void)lane; (void)gw; if (lw.mixer == 0) phase_kmean(QKV + D, lw.Nq, kmean, lds, tid); SEAM(base + 2); }
        if (IN(base + 3)) {
            constexpr int mixer_c = layer % 3;
            if constexpr (mixer_c == 0) { if (ATTN_MFMA_MASK & 1) att::attn_phase<0>(QKV, 3 * D, D, 2 * D, 1, Ob, kmean, nullptr, lds, wave0); }
            else if constexpr (mixer_c == 1) { if (ATTN_MFMA_MASK & 2) att::attn_phase<1>(QKV, 1536, D, D + 256, 4, Ob, nullptr, args.in[6] + (layer / 3) * NH, lds, wave0); }
            else { if (ATTN_MFMA_MASK & 4) att::attn_phase<2>(QKV, 3 * D, D, 2 * D, 1, Ob, nullptr, nullptr, lds, wave0); }
            SEAM(base + 3);
        }
        if (IN(base + 4)) {
            pg8::DenseOrder S; S.init(Ob, (const bf16_t*)(ws + WS_WO), M, D, D, G, (int)blockIdx.x);
            pg8::EpiResF32 E{xres, T};
            pg8::gemm_phase<pg8::EpiResF32, pg8::DenseOrder, true, false>(lds, D, S, E, wave0);
            SEAM(base + 4);
        }
        if (IN(base + 5)) {
            OPQ(); phase_ln1_route(T, args.in[9] + layer * D, args.in[10] + layer * D, X, xb_oth, args.in[13] + (size_t)layer * D * 4, args.in[14] + layer * 4,
                            args.in[15] + (size_t)layer * D * 32, args.in[16] + layer * 32, cnt, list, ti, lds, tid, gw, NGW, lane);
            SEAM(base + 5);
        }
        if (IN(base + 6)) {
            { OPQ(); (void)lane; (void)gw; moe_tables(cnt, tbl, tid); }
            pg8::MoeOrder S; S.A = xb_oth; S.Bt = (const bf16_t*)(ws + WS_W1); S.K = D; S.strideB = (size_t)1024 * D; S.list = list; S.tbl = tbl; S.G = G; S.c = (int)blockIdx.x;
            pg8::EpiSwiglu E{Hb};
            pg8::gemm_phase<pg8::EpiSwiglu, pg8::MoeOrder, true, true>(lds, D, S, E, wave0);
            SEAM(base + 6);
        }
        if (IN(base + 7)) {
            { OPQ(); (void)lane; (void)gw; moe_tables(cnt, tbl, tid); }
            pg8::MoeOrder2 S; S.A = Hb; S.Bt = (const bf16_t*)(ws + WS_W2); S.K = DE; S.strideB = (size_t)1024 * DE; S.list = list; S.tbl = tbl; S.G = G; S.c = (int)blockIdx.x;
            pg8::EpiStoreBf16 E{Yb, D, 1.f, 0};
            pg8::gemm_phase<pg8::EpiStoreBf16, pg8::MoeOrder2, true, false>(lds, DE, S, E, wave0);
            SEAM(base + 7);
        }
        if (IN(base + 8)) {
            OPQ(); moe_tables(cnt, tbl, tid);
            phase_ln2(X, Yb, ti, tbl, args.in[11] + layer * D, args.in[12] + layer * D, xb_cur, gw, NGW, lane);
            SEAM(base + 8);
        }
        if (IN(base + 9)) {
            pg8::DenseOrder S; S.init(xb_cur, (const bf16_t*)(ws + WS_WPG), M, D, D, G, (int)blockIdx.x);
            pg8::EpiPle E{X, (layer == DEPTH - 1) ? args.out : X, PP, xb_oth};
            pg8::gemm_phase<pg8::EpiPle, pg8::DenseOrder, true, false>(lds, D, S, E, wave0);
            SEAM(base + 9);
        }
    }
#undef IN
#undef SEAM
#undef OPQ
}
__global__ void __launch_bounds__(NTHREADS, 2) mk_fwd(Args args) {
    extern __shared__ __attribute__((aligned(16))) unsigned char lds_raw[];
    LAS unsigned char* lds = (LAS unsigned char*)lds_raw;
    const int tid0 = threadIdx.x; const int wave0 = __builtin_amdgcn_readfirstlane(tid0 >> 6);
    volatile LAS unsigned* MISC = (volatile LAS unsigned*)(lds + MISC_OFF);
    for (int u = tid0; u < 256; u += NTHREADS) MISC[u] = 0u;
    __syncthreads();
    unsigned char* ws = args.ws;
    unsigned* ctl = (unsigned*)(ws + WS_CTL);
    XcdBarrier bar = xcd_barrier_post(ctl + CW_BAR + args.li * XCD_BAR_WORDS, MISC + MISC_BAR);
    KCtx kc; kc.lds = lds; kc.tbl = (LAS int*)(lds + MISC_OFF) + MISC_TBL; kc.ws = ws; kc.ctl = ctl; kc.lo = args.ph_lo; kc.hi = args.ph_hi; kc.G = gridDim.x; kc.NGW = gridDim.x * NWAVES; kc.wave0 = wave0;
    run_layer<0>(args, kc, bar); run_layer<1>(args, kc, bar); run_layer<2>(args, kc, bar); run_layer<3>(args, kc, bar);
}

extern "C" void kernel_launch(void* const* d_in, const int* in_sizes, int n_in, void* d_out, int out_size, void* d_ws, size_t ws_size, hipStream_t stream) {
    static int grid = 0;
    if (grid == 0) {
        if (n_in != 22 || ws_size < WS_END) { fprintf(stderr, "kernel_launch: unexpected inputs (n_in %d, ws %zu)\n", n_in, ws_size); grid = -1; return; }
        int dev = 0, cus = 0;
        if (hipGetDevice(&dev) != hipSuccess || hipDeviceGetAttribute(&cus, hipDeviceAttributeMultiprocessorCount, dev) != hipSuccess) { grid = -1; return; }
        if (hipFuncSetAttribute((const void*)mk_fwd, hipFuncAttributeMaxDynamicSharedMemorySize, LDS_BYTES) != hipSuccess) { fprintf(stderr, "kernel_launch: hipFuncSetAttribute failed\n"); grid = -1; return; }
        int per_cu = 0;
        if (hipOccupancyMaxActiveBlocksPerMultiprocessor(&per_cu, (const void*)mk_fwd, NTHREADS, LDS_BYTES) != hipSuccess || per_cu < 1) { fprintf(stderr, "kernel_launch: occupancy query says %d\n", per_cu); }
        (void)hipGetLastError();
        grid = cus;
    }
    if (grid < 0) return;
    (void)hipMemsetAsync((char*)d_ws + WS_CTL, 0, CTL_ZERO_BYTES, stream);
    Args a{};
    for (int i = 0; i < 22; ++i) a.in[i] = (const float*)d_in[i];
    a.out = (float*)d_out; a.ws = (unsigned char*)d_ws;
    unsigned char* ws = (unsigned char*)d_ws;
    int li = 0, seg_lo = 0;
    const float inv_c2 = 1.0f / (0.125f * LOG2E);
    for (int layer = 0; layer < DEPTH; ++layer) {
        const int mixer = layer % 3, j = layer / 3, base = layer * NPH;
        if ((ATTN_MFMA_MASK >> mixer) & 1) continue;
        a.ph_lo = seg_lo; a.ph_hi = base + 3; a.li = li++;
        hipLaunchKernelGGL(mk_fwd, dim3(grid), dim3(NTHREADS), LDS_BYTES, stream, a);
        const bf16_t* QKV = (const bf16_t*)(ws + WS_QKV); bf16_t* Ob = (bf16_t*)(ws + WS_O); const float* kmean = (const float*)(ws + WS_KMEAN);
        if (mixer == 0) hipLaunchKernelGGL(k_attn<0>, dim3(8, 16, 16), dim3(256), 0, stream, QKV, 3 * D, QKV + D, QKV + 2 * D, 3 * D, 1, Ob, kmean, (const float*)nullptr, inv_c2);
        else if (mixer == 1) hipLaunchKernelGGL(k_attn<1>, dim3(8, 16, 16), dim3(256), 0, stream, QKV, 1536, QKV + D, QKV + D + 256, 1536, 4, Ob, (const float*)nullptr, (const float*)d_in[6] + j * NH, inv_c2);
        else hipLaunchKernelGGL(k_attn<2>, dim3(8, 16, 16), dim3(256), 0, stream, QKV, 3 * D, QKV + D, QKV + 2 * D, 3 * D, 1, Ob, (const float*)nullptr, (const float*)nullptr, inv_c2);
        seg_lo = base + 4;
    }
    a.ph_lo = seg_lo; a.ph_hi = DEPTH * NPH; a.li = li++;
    hipLaunchKernelGGL(mk_fwd, dim3(grid), dim3(NTHREADS), LDS_BYTES, stream, a);
}
```

```cpp
#include <hip/hip_runtime.h>
#include <cstdint>
#include <cstdio>
#include <cmath>

#define LAS __attribute__((address_space(3)))
#define GAS __attribute__((address_space(1)))
typedef unsigned short bf16_t;
typedef short bf16x8 __attribute__((ext_vector_type(8)));
typedef float f32x4 __attribute__((ext_vector_type(4)));
typedef float f32x2 __attribute__((ext_vector_type(2)));
typedef unsigned u32x4 __attribute__((ext_vector_type(4)));
typedef unsigned u32x2 __attribute__((ext_vector_type(2)));

constexpr int D = 1024, BATCH = 16, SEQ = 2048, DEPTH = 4, M = BATCH * SEQ;
constexpr int HD = 64, NH = 16, NE = 32, DE = 512, PLE = 256;
constexpr int NSLOT = 65536 + 32 * 256;
constexpr float ALPHA = 1.681792830507429f;
constexpr float LN_EPS = 1e-5f;
constexpr float LOG2E = 1.4426950408889634f;
constexpr int NWAVES = 8, NTHREADS = 512;
constexpr int NPH = 10;
#ifndef REP_PHASE
#define REP_PHASE -1
#endif
#define REPS(k) ((REP_PHASE == (k)) ? 2 : 1)
#ifndef ATTN_MFMA_MASK
#define ATTN_MFMA_MASK 7
#endif

constexpr size_t MiB = 1u << 20;
constexpr size_t WS_CTL = 0, CTL_ZERO_BYTES = 2 * MiB;
constexpr size_t WS_TI = 2 * MiB;
constexpr size_t WS_KMEAN = 3 * MiB;
constexpr size_t WS_LIST = 4 * MiB;
constexpr size_t WS_WQKV = 8 * MiB;
constexpr size_t WS_WO = 14 * MiB;
constexpr size_t WS_W1 = 16 * MiB;
constexpr size_t WS_W2 = 80 * MiB;
constexpr size_t WS_WPG = 112 * MiB;
constexpr size_t WS_WPP = 114 * MiB;
constexpr size_t WS_PB = 115 * MiB;
constexpr size_t WS_WRF = 131 * MiB;
constexpr size_t WS_X = 132 * MiB;
constexpr size_t WS_XBA = 260 * MiB, WS_XBB = 324 * MiB;
constexpr size_t WS_R = 388 * MiB;
constexpr size_t WS_QKV = WS_R, WS_O = WS_R + 192 * MiB, WS_T = WS_R, WS_H = WS_R, WS_Y = WS_R + 72 * MiB;
constexpr size_t WS_PP = 644 * MiB;
constexpr size_t WS_END = 708 * MiB;
constexpr int CW_TMO = 0;
constexpr int CW_BAR = 8192;
constexpr int CW_CNT = 1024;

struct TokInfo { int e0, p0, e1, p1; float g0, g1; int pad0, pad1; };

constexpr int RING_BYTES = 131072;
constexpr int ROUTER_TBL_BYTES = 1024 * 36 * 4;
constexpr int MISC_OFF = 147456;
constexpr int MISC_BAR = 0;
constexpr int MISC_TBL = 16;
constexpr int LDS_BYTES = MISC_OFF + 1024;

__device__ __forceinline__ float bf2f(bf16_t v) { return __uint_as_float((unsigned)v << 16); }
__device__ __forceinline__ unsigned cvt_pk_bf16(float lo, float hi) { unsigned r; asm volatile("v_cvt_pk_bf16_f32 %0, %1, %2" : "=v"(r) : "v"(lo), "v"(hi)); return r; }
__device__ __forceinline__ float wave_sum(float v) {
#pragma unroll
    for (int o = 1; o < 64; o <<= 1) v += __shfl_xor(v, o);
    return v;
}

namespace pg8 {
#define PG8_LAS __attribute__((address_space(3)))
constexpr int BM = 256, BK = 64, HALF = 128, HTB = HALF * BK * 2  , STAGE_BYTES = 8 * HTB, NXCD = 8, WGM = 8;

__host__ __device__ __forceinline__ int lds_byte(int r, int c) { const int st = (r >> 4) * 2 + (c >> 5), rr = r & 15, cc = c & 31, ob = rr * 64 + cc * 2; return st * 1024 + (ob ^ (((ob >> 9) & 1) << 5)); }
__host__ __device__ __forceinline__ void stage_rc(int b, int& R, int& C) { const int st = b / 1024, sb = b % 1024, swz = sb ^ (((sb >> 9) & 1) << 5); R = (st >> 1) * 16 + swz / 64; C = (st & 1) * 32 + (swz % 64) / 2; }
__host__ __device__ __forceinline__ int perm32(int rho) { const int n = rho >> 4, i = rho & 15; return 8 * (i >> 2) + 4 * n + (i & 3); }

struct Unit { int pm, pn, e, lt; };

struct DenseOrder {
    const bf16_t* A; const bf16_t* Bt; int K;
    int nM, nN, nwg, G, c;
    __device__ __forceinline__ void init(const bf16_t* A_, const bf16_t* Bt_, int M_, int N_, int K_, int G_, int c_) { A = A_; Bt = Bt_; K = K_; nM = M_ / BM; nN = N_ / BM; nwg = nM * nN; G = G_; c = c_; }
    __device__ __forceinline__ bool next(int i, Unit& u) const {
        const long L = (long)i * G + c; if (L >= nwg) return false;
        int wgid = (int)L; { const int q = nwg / NXCD, r = nwg % NXCD, xcd = wgid % NXCD, off = wgid / NXCD; wgid = (xcd < r ? xcd * (q + 1) : r * (q + 1) + (xcd - r) * q) + off; }
        const int nig = WGM * nN, gid = wgid / nig, fm = gid * WGM, gsz = (nM - fm) < WGM ? (nM - fm) : WGM;
        u.pm = fm + ((wgid % nig) % gsz); u.pn = (wgid % nig) / gsz; u.e = 0; u.lt = 0; return true;
    }
    __device__ __forceinline__ const char* a_ptr(const Unit& u) const { return (const char*)A + (size_t)u.pm * BM * K * 2; }
    __device__ __forceinline__ const char* b_ptr(const Unit& u) const { return (const char*)Bt + (size_t)u.pn * BM * K * 2; }
    __device__ __forceinline__ int row_tok(const Unit&, int) const { return 0; }
};
struct MoeOrder {
    const bf16_t* A; const bf16_t* Bt; int K; size_t strideB;
    const int* list; PG8_LAS const int* tbl; int G, c;
    __device__ __forceinline__ bool next(int i, Unit& u) const {
        const int L = i * G + c, rt = L >> 2; if (rt >= tbl[32]) return false;
        u.pn = L & 3; int e = 0;
#pragma unroll
        for (int k = 1; k < 32; ++k) e += (rt >= tbl[k]) ? 1 : 0;
        u.e = e; u.lt = rt - tbl[e]; u.pm = rt; return true;
    }
    __device__ __forceinline__ const char* a_ptr(const Unit& u) const { return (const char*)A; }
    __device__ __forceinline__ const char* a_ptr_compact(const Unit& u) const { return (const char*)A + (size_t)u.pm * BM * K * 2; }
    __device__ __forceinline__ const char* b_ptr(const Unit& u) const { return (const char*)Bt + ((size_t)u.e * strideB + (size_t)u.pn * BM * K) * 2; }
    __device__ __forceinline__ int row_tok(const Unit& u, int r) const { const int pos = u.lt * BM + r; return pos < tbl[33 + u.e] ? list[(size_t)u.e * M + pos] : 0; }
};
struct MoeOrder2 : MoeOrder {
    __device__ __forceinline__ const char* a_ptr(const Unit& u) const { return a_ptr_compact(u); }
};

struct EpiStoreBf16 {
    static constexpr bool PERM = true;
    bf16_t* O; int ldc; float scale0; int scale_cols;
    __device__ __forceinline__ void operator()(const f32x4 (&acc)[2][2][4][2], const Unit& u, int wr, int wc, int fr, int fq) const {
        const int row0 = u.pm * BM + wr * 64 + fr, col0 = u.pn * BM + wc * 32 + 8 * fq;
        const float sc = (u.pn * BM < scale_cols) ? scale0 : 1.f;
#pragma unroll
        for (int ai = 0; ai < 2; ++ai)
#pragma unroll
            for (int m = 0; m < 4; ++m) { bf16_t* rowp = O + (size_t)(row0 + ai * HALF + m * 16) * ldc + col0;
#pragma unroll
                for (int bj = 0; bj < 2; ++bj) { const f32x4 v0 = acc[ai][bj][m][0] * sc, v1 = acc[ai][bj][m][1] * sc;
                    u32x4 w; w.x = cvt_pk_bf16(v0[0], v0[1]); w.y = cvt_pk_bf16(v0[2], v0[3]); w.z = cvt_pk_bf16(v1[0], v1[1]); w.w = cvt_pk_bf16(v1[2], v1[3]);
                    *(u32x4*)(rowp + bj * HALF) = w; } }
    }
};
struct EpiResF32 {
    static constexpr bool PERM = false;
    const float* xres; float* T;
    __device__ __forceinline__ void operator()(const f32x4 (&acc)[2][2][4][2], const Unit& u, int wr, int wc, int fr, int fq) const {
        const int row0 = u.pm * BM + wr * 64 + fr, col0 = u.pn * BM + wc * 32 + 4 * fq;
#pragma unroll
        for (int ai = 0; ai < 2; ++ai)
#pragma unroll
            for (int m = 0; m < 4; ++m) { const size_t off = (size_t)(row0 + ai * HALF + m * 16) * D + col0;
#pragma unroll
                for (int bj = 0; bj < 2; ++bj)
#pragma unroll
                    for (int n = 0; n < 2; ++n) { const f32x4 xr = *(const f32x4*)(xres + off + bj * HALF + n * 16); *(f32x4*)(T + off + bj * HALF + n * 16) = xr * ALPHA + acc[ai][bj][m][n]; } }
    }
};
__device__ __forceinline__ float silu_f(float g) { return g * __builtin_amdgcn_rcpf(1.f + __builtin_amdgcn_exp2f(-g * LOG2E)); }
__device__ __forceinline__ float sigmoid_f(float g) { return __builtin_amdgcn_rcpf(1.f + __builtin_amdgcn_exp2f(-g * LOG2E)); }
struct EpiSwiglu {
    static constexpr bool PERM = true;
    bf16_t* H;
    __device__ __forceinline__ void operator()(const f32x4 (&acc)[2][2][4][2], const Unit& u, int wr, int wc, int fr, int fq) const {
        const int row0 = u.pm * BM + wr * 64 + fr, col0 = u.pn * HALF + wc * 32 + 8 * fq;
#pragma unroll
        for (int ai = 0; ai < 2; ++ai)
#pragma unroll
            for (int m = 0; m < 4; ++m) { bf16_t* rowp = H + (size_t)(row0 + ai * HALF + m * 16) * DE + col0;
                const f32x4 g0 = acc[ai][0][m][0], g1 = acc[ai][0][m][1], u0 = acc[ai][1][m][0], u1 = acc[ai][1][m][1];
                u32x4 w; w.x = cvt_pk_bf16(silu_f(g0[0]) * u0[0], silu_f(g0[1]) * u0[1]); w.y = cvt_pk_bf16(silu_f(g0[2]) * u0[2], silu_f(g0[3]) * u0[3]);
                w.z = cvt_pk_bf16(silu_f(g1[0]) * u1[0], silu_f(g1[1]) * u1[1]); w.w = cvt_pk_bf16(silu_f(g1[2]) * u1[2], silu_f(g1[3]) * u1[3]);
                *(u32x4*)rowp = w; }
    }
};
struct EpiPle {
    static constexpr bool PERM = true;
    const float* xin; float* xout; const bf16_t* PP; bf16_t* xb;
    __device__ __forceinline__ void operator()(const f32x4 (&acc)[2][2][4][2], const Unit& u, int wr, int wc, int fr, int fq) const {
        const int row0 = u.pm * BM + wr * 64 + fr, col0 = u.pn * BM + wc * 32 + 8 * fq;
#pragma unroll
        for (int ai = 0; ai < 2; ++ai)
#pragma unroll
            for (int m = 0; m < 4; ++m) { const size_t off = (size_t)(row0 + ai * HALF + m * 16) * D + col0;
#pragma unroll
                for (int bj = 0; bj < 2; ++bj) { const size_t o2 = off + bj * HALF;
                    const f32x4 x0 = *(const f32x4*)(xin + o2), x1 = *(const f32x4*)(xin + o2 + 4); const u32x4 pp = *(const u32x4*)(PP + o2);
                    const f32x4 a0 = acc[ai][bj][m][0], a1 = acc[ai][bj][m][1];
                    f32x4 r0, r1;
                    r0[0] = x0[0] + sigmoid_f(a0[0]) * __uint_as_float(pp.x << 16); r0[1] = x0[1] + sigmoid_f(a0[1]) * __uint_as_float(pp.x & 0xffff0000u);
                    r0[2] = x0[2] + sigmoid_f(a0[2]) * __uint_as_float(pp.y << 16); r0[3] = x0[3] + sigmoid_f(a0[3]) * __uint_as_float(pp.y & 0xffff0000u);
                    r1[0] = x1[0] + sigmoid_f(a1[0]) * __uint_as_float(pp.z << 16); r1[1] = x1[1] + sigmoid_f(a1[1]) * __uint_as_float(pp.z & 0xffff0000u);
                    r1[2] = x1[2] + sigmoid_f(a1[2]) * __uint_as_float(pp.w << 16); r1[3] = x1[3] + sigmoid_f(a1[3]) * __uint_as_float(pp.w & 0xffff0000u);
                    *(f32x4*)(xout + o2) = r0; *(f32x4*)(xout + o2 + 4) = r1;
                    u32x4 w; w.x = cvt_pk_bf16(r0[0], r0[1]); w.y = cvt_pk_bf16(r0[2], r0[3]); w.z = cvt_pk_bf16(r1[0], r1[1]); w.w = cvt_pk_bf16(r1[2], r1[3]);
                    *(u32x4*)(xb + o2) = w; } }
    }
};

template <class Epi, class Sched, bool ALIGN_EPI, bool GATHER>
__device__ __forceinline__ void gemm_phase(PG8_LAS unsigned char* lds, const int K, const Sched& S, const Epi& E, const int wave0) {
    int tid_ = wave0 * 64 + (int)__builtin_amdgcn_mbcnt_hi(~0u, __builtin_amdgcn_mbcnt_lo(~0u, 0u)); asm volatile("" : "+v"(tid_));
    const int tid = tid_, wid = __builtin_amdgcn_readfirstlane(tid >> 6), lane = tid & 63, wr = wid >> 2, wc = wid & 3, fr = lane & 15, fq = lane >> 4;
    const int nt = K / BK;
    unsigned voffB[2]; int RA[2]; unsigned CA2[2];
#pragma unroll
    for (int i = 0; i < 2; ++i) { int R, C; stage_rc(tid * 16 + i * 8192, R, C); const int Rb = Epi::PERM ? ((R & ~31) + perm32(R & 31)) : R;
        RA[i] = R; CA2[i] = (unsigned)C * 2u; voffB[i] = (unsigned)(Rb * K + C) * 2u; }
    const size_t kstep = (size_t)(BK * 2);
    const size_t hstep = (size_t)HALF * K * 2;
    const size_t hstepA = GATHER ? (size_t)0 : hstep;
    const unsigned ldsw = (unsigned)wid * 1024u;
    const int aoff = lds_byte(wr * 64 + fr, fq * 8), boff = lds_byte(wc * 32 + fr, fq * 8);
#define PG8_SA(b, h) (((b) * 2 + (h)) * HTB)
#define PG8_SB(b, h) ((4 + (b) * 2 + (h)) * HTB)
#define PG8_STAGE(bufoff, gbase, voff) do { _Pragma("unroll") for (int _i = 0; _i < 2; ++_i) \
        __builtin_amdgcn_global_load_lds((const unsigned*)((const char*)(gbase) + (voff)[_i]), (PG8_LAS unsigned*)(lds + (bufoff) + ldsw + _i * 8192), 16, 0, 0); } while (0)
#define PG8_LDA(dst, b, h) do { _Pragma("unroll") for (int m = 0; m < 4; ++m) _Pragma("unroll") for (int k = 0; k < 2; ++k) dst[m][k] = *(const PG8_LAS bf16x8*)(lds + PG8_SA(b, h) + aoff + m * 2048 + k * 1024); } while (0)
#define PG8_LDB(dst, b, h) do { _Pragma("unroll") for (int n = 0; n < 2; ++n) _Pragma("unroll") for (int k = 0; k < 2; ++k) dst[n][k] = *(const PG8_LAS bf16x8*)(lds + PG8_SB(b, h) + boff + n * 2048 + k * 1024); } while (0)
#define PG8_MMA(ai, bj, At, Bt) do { __builtin_amdgcn_s_setprio(1); _Pragma("unroll") for (int m = 0; m < 4; ++m) _Pragma("unroll") for (int n = 0; n < 2; ++n) _Pragma("unroll") for (int k = 0; k < 2; ++k) \
        acc[ai][bj][m][n] = __builtin_amdgcn_mfma_f32_16x16x32_bf16(Bt[n][k], At[m][k], acc[ai][bj][m][n], 0, 0, 0); __builtin_amdgcn_s_setprio(0); } while (0)
#define PG8_WAIT_V(n) asm volatile("s_waitcnt vmcnt(" #n ")" ::: "memory")
#define PG8_WAIT_L(n) asm volatile("s_waitcnt lgkmcnt(" #n ")" ::: "memory")
#define PG8_BAR __builtin_amdgcn_s_barrier()
#define PG8_SCHED __builtin_amdgcn_sched_barrier(0)
#define PG8_GOFF(dst, u) do { _Pragma("unroll") for (int _h = 0; _h < 2; ++_h) _Pragma("unroll") for (int _i = 0; _i < 2; ++_i) \
        dst[_h][_i] = GATHER ? ((unsigned)S.row_tok(u, _h * HALF + RA[_i]) * (unsigned)(K * 2) + CA2[_i]) : ((unsigned)(RA[_i] * K) * 2u + CA2[_i]); } while (0)
    Unit cur, nxt; int ui = 0;
    if (!S.next(0, cur)) return;
    f32x4 acc[2][2][4][2];
#pragma unroll
    for (int a = 0; a < 2; ++a)
#pragma unroll
        for (int b = 0; b < 2; ++b)
#pragma unroll
            for (int m = 0; m < 4; ++m)
#pragma unroll
                for (int n = 0; n < 2; ++n) acc[a][b][m][n] = (f32x4){0.f, 0.f, 0.f, 0.f};
    bf16x8 At[4][2], B0[2][2], B1[2][2];
    unsigned gc[2][2], gn[2][2];
    PG8_GOFF(gc, cur);
    const char* cA = S.a_ptr(cur); const char* cB = S.b_ptr(cur);
    PG8_STAGE(PG8_SB(0, 0), cB, voffB); PG8_STAGE(PG8_SB(0, 1), cB + hstep, voffB); PG8_STAGE(PG8_SA(0, 0), cA, gc[0]); PG8_STAGE(PG8_SA(0, 1), cA + hstepA, gc[1]);
    if (wr == 1) PG8_BAR;
    PG8_WAIT_V(2); PG8_BAR;
    PG8_STAGE(PG8_SB(1, 0), cB + kstep, voffB); PG8_STAGE(PG8_SA(1, 0), cA + kstep, gc[0]); PG8_STAGE(PG8_SB(1, 1), cB + hstep + kstep, voffB);
    PG8_WAIT_V(6); PG8_BAR;
    for (;;) {
        const bool has_next = S.next(ui + 1, nxt);
        const char* nA = has_next ? S.a_ptr(nxt) : cA; const char* nB = has_next ? S.b_ptr(nxt) : cB;
        if (GATHER) { if (has_next) { PG8_GOFF(gn, nxt); } else {
#pragma unroll
            for (int h = 0; h < 2; ++h)
#pragma unroll
                for (int i = 0; i < 2; ++i) gn[h][i] = gc[h][i]; } }
        for (int t = 0; t < nt; t += 2) {
            const bool last = (t == nt - 2);
            const char* a1 = cA + (size_t)(t + 1) * kstep;
            const char* a2 = last ? nA : cA + (size_t)(t + 2) * kstep; const char* b2 = last ? nB : cB + (size_t)(t + 2) * kstep;
            const char* a3 = a2 + kstep; const char* b3 = b2 + kstep;
            unsigned gs[2][2];
#pragma unroll
            for (int h = 0; h < 2; ++h)
#pragma unroll
                for (int i = 0; i < 2; ++i) gs[h][i] = (GATHER && last) ? gn[h][i] : gc[h][i];
            PG8_LDB(B0, 0, 0); PG8_LDB(B1, 0, 1); PG8_SCHED; PG8_LDA(At, 0, 0); PG8_STAGE(PG8_SA(1, 1), a1 + hstepA, gc[1]);
            PG8_WAIT_V(8); PG8_WAIT_L(0); PG8_BAR; PG8_MMA(0, 0, At, B0); PG8_MMA(0, 1, At, B1); PG8_BAR; PG8_SCHED;
            PG8_LDA(At, 0, 1); PG8_STAGE(PG8_SB(0, 0), b2, voffB); PG8_STAGE(PG8_SB(0, 1), b2 + hstep, voffB); PG8_STAGE(PG8_SA(0, 0), a2, gs[0]);
            PG8_WAIT_V(8); PG8_WAIT_L(0); PG8_BAR; PG8_MMA(1, 0, At, B0); PG8_MMA(1, 1, At, B1); PG8_BAR; PG8_SCHED;
            PG8_LDB(B0, 1, 0); PG8_LDB(B1, 1, 1); PG8_SCHED; PG8_LDA(At, 1, 0); PG8_STAGE(PG8_SA(0, 1), a2 + hstepA, gs[1]);
            PG8_WAIT_V(8); PG8_WAIT_L(0); PG8_BAR; PG8_MMA(0, 0, At, B0); PG8_MMA(0, 1, At, B1); PG8_BAR; PG8_SCHED;
            PG8_LDA(At, 1, 1); PG8_STAGE(PG8_SB(1, 0), b3, voffB); PG8_STAGE(PG8_SB(1, 1), b3 + hstep, voffB); PG8_STAGE(PG8_SA(1, 0), a3, gs[0]);
            PG8_WAIT_V(8); PG8_WAIT_L(0); PG8_BAR; PG8_MMA(1, 0, At, B0); PG8_MMA(1, 1, At, B1); PG8_BAR; PG8_SCHED;
        }
        if constexpr (ALIGN_EPI) { if (wr == 0) PG8_BAR; }
        E(acc, cur, wr, wc, fr, fq);
        if (!has_next) break;
#pragma unroll
        for (int a = 0; a < 2; ++a)
#pragma unroll
            for (int b = 0; b < 2; ++b)
#pragma unroll
                for (int m = 0; m < 4; ++m)
#pragma unroll
                    for (int n = 0; n < 2; ++n) acc[a][b][m][n] = (f32x4){0.f, 0.f, 0.f, 0.f};
        cur = nxt; cA = nA; cB = nB; ++ui;
#pragma unroll
        for (int h = 0; h < 2; ++h)
#pragma unroll
            for (int i = 0; i < 2; ++i) gc[h][i] = gn[h][i];
        if constexpr (ALIGN_EPI) { if (wr == 1) PG8_BAR; }
    }
    PG8_WAIT_V(0);
    if constexpr (!ALIGN_EPI) { if (wr == 0) PG8_BAR; }
    PG8_BAR;
#undef PG8_SA
#undef PG8_SB
#undef PG8_STAGE
#undef PG8_LDA
#undef PG8_LDB
#undef PG8_MMA
#undef PG8_WAIT_V
#undef PG8_WAIT_L
#undef PG8_BAR
#undef PG8_SCHED
#undef PG8_GOFF
}
}

#define XB_TMO      128
#define XB_XCNT(j)  (256  + 64 * (j))
#define XB_XSUB(j)  (1280 + 64 * (j))
#define XB_XGEN(j)  (2304 + 64 * (j))
#define XB_TOP      3328
#define XB_TOPGEN   3392
#define XCD_BAR_WORDS 3456
#define XB_SPIN_CAP (1u << 18)

__device__ __forceinline__ unsigned xb_ld(unsigned* p)              { return __hip_atomic_load(p, __ATOMIC_RELAXED, __HIP_MEMORY_SCOPE_AGENT); }
__device__ __forceinline__ unsigned xb_add(unsigned* p, unsigned v) { return __hip_atomic_fetch_add(p, v, __ATOMIC_RELAXED, __HIP_MEMORY_SCOPE_AGENT); }
__device__ __forceinline__ unsigned xb_xcc_id() { return (unsigned)__builtin_amdgcn_s_getreg((3 << 11) | 20) & 0xFu; }
#define XB_SPIN(cond, bar) do { unsigned _sp = 0; while (cond) { __builtin_amdgcn_s_sleep(1); \
    if ((++_sp & 255u) == 0u) { if (xb_ld(&(bar)[XB_TMO])) break; if (_sp > XB_SPIN_CAP) { atomicAdd(&(bar)[XB_TMO], 1u); break; } } } } while (0)

struct XcdBarrier {
    unsigned* bar; unsigned x;
    volatile LAS unsigned* st;
};
__device__ __forceinline__ XcdBarrier xcd_barrier_post(unsigned* bar, volatile LAS unsigned* st) {
    XcdBarrier b; b.bar = bar; b.x = xb_xcc_id(); b.st = st;
    if (threadIdx.x == 0) (void)xb_add(&bar[XB_XCNT(b.x)], 1u);
    return b;
}
__device__ __forceinline__ void xcd_barrier_complete(unsigned* bar, unsigned x, unsigned& nloc, unsigned& nx) {
    const unsigned G = gridDim.x * gridDim.y * gridDim.z;
    unsigned sum, cnt, mine, sp = 0u;
    for (;;) {
        sum = 0u; cnt = 0u; mine = 0u;
#pragma unroll
        for (unsigned j = 0; j < 16; ++j) { const unsigned c = xb_ld(&bar[XB_XCNT(j)]); sum += c; cnt += (c > 0u) ? 1u : 0u; mine = (j == x) ? c : mine; }
        if (sum == G) break;
        __builtin_amdgcn_s_sleep(1);
        if ((++sp & 255u) == 0u) { if (xb_ld(&bar[XB_TMO])) break; if (sp > XB_SPIN_CAP) { atomicAdd(&bar[XB_TMO], 1u); break; } }
    }
    nloc = mine > 0u ? mine : 1u; nx = cnt > 0u ? cnt : 1u;
}
__device__ __forceinline__ void xcd_barrier(const XcdBarrier& b) {
    asm volatile("s_waitcnt vmcnt(0)" ::: "memory");
    __syncthreads();
    if (threadIdx.x == 0) {
        unsigned* bar = b.bar;
        __builtin_amdgcn_s_waitcnt(0);
        unsigned nloc = b.st[0], nx = b.st[1];
        if (nloc == 0u) { xcd_barrier_complete(bar, b.x, nloc, nx); b.st[0] = nloc; b.st[1] = nx; }
        const unsigned old = xb_add(&bar[XB_XSUB(b.x)], 1u);
        const unsigned gen = old / nloc;
        if (old + 1u == (gen + 1u) * nloc) {
            __builtin_amdgcn_fence(__ATOMIC_RELEASE, "agent");
            asm volatile("s_waitcnt vmcnt(0)" ::: "memory");
            const unsigned og = xb_add(&bar[XB_TOP], 1u);
            const unsigned tg = og / nx;
            if (og + 1u == (tg + 1u) * nx) xb_add(&bar[XB_TOPGEN], 1u);
            else XB_SPIN(xb_ld(&bar[XB_TOPGEN]) == tg, bar);
            __builtin_amdgcn_fence(__ATOMIC_ACQUIRE, "agent");
            xb_add(&bar[XB_XGEN(b.x)], 1u);
            asm volatile("s_waitcnt vmcnt(0)" ::: "memory");
        } else {
            XB_SPIN(xb_ld(&bar[XB_XGEN(b.x)]) == gen, bar);
            __builtin_amdgcn_fence(__ATOMIC_ACQUIRE, "agent");
            asm volatile("s_waitcnt vmcnt(0)" ::: "memory");
        }
    }
    __syncthreads();
}

#define LDS_WAIT() asm volatile("s_waitcnt lgkmcnt(0)" ::: "memory")
__device__ __forceinline__ void transpose_item(const float* __restrict__ W, int N, int k0, int n0, bf16_t* __restrict__ out, int ldo, LAS float* scr, int lane) {
#pragma unroll 8
    for (int i = 0; i < 32; ++i) { const int kk = 2 * i + (lane >> 5); scr[kk * 33 + (lane & 31)] = W[(size_t)(k0 + kk) * N + n0 + (lane & 31)]; }
    LDS_WAIT(); asm volatile("" ::: "memory");
    const int c = lane & 7;
#pragma unroll
    for (int j = 0; j < 4; ++j) { const int n = (lane >> 3) + 8 * j; const LAS float* s = scr + (8 * c) * 33 + n;
        u32x4 o; o.x = cvt_pk_bf16(s[0 * 33], s[1 * 33]); o.y = cvt_pk_bf16(s[2 * 33], s[3 * 33]); o.z = cvt_pk_bf16(s[4 * 33], s[5 * 33]); o.w = cvt_pk_bf16(s[6 * 33], s[7 * 33]);
        *(u32x4*)(out + (size_t)n * ldo + 8 * c) = o; }
    LDS_WAIT(); asm volatile("" ::: "memory");
}
__device__ __forceinline__ void cvt_rows(const float* __restrict__ src, bf16_t* __restrict__ dst, long nchunks, int gw, int NGW, int lane) {
    for (long c = gw; c < nchunks; c += NGW) {
        const float* s = src + c * 512 + lane * 8; const f32x4 a = *(const f32x4*)s, b = *(const f32x4*)(s + 4);
        u32x4 o; o.x = cvt_pk_bf16(a[0], a[1]); o.y = cvt_pk_bf16(a[2], a[3]); o.z = cvt_pk_bf16(b[0], b[1]); o.w = cvt_pk_bf16(b[2], b[3]);
        *(u32x4*)(dst + c * 512 + lane * 8) = o;
    }
}

struct Args { const float* in[22]; float* out; unsigned char* ws; int ph_lo, ph_hi, li, pad; };

struct LayerW { const float* wqkv; const float* wo; int Nq; int mixer; };
__device__ __forceinline__ const float* sel3(int mixer, const float* p0, const float* p1, const float* p2) {
    const uintptr_t m0 = (uintptr_t)0 - (uintptr_t)(mixer == 0), m1 = (uintptr_t)0 - (uintptr_t)(mixer == 1), m2 = (uintptr_t)0 - (uintptr_t)(mixer == 2);
    return (const float*)(((uintptr_t)p0 & m0) | ((uintptr_t)p1 & m1) | ((uintptr_t)p2 & m2));
}
__device__ __forceinline__ LayerW layer_weights(const float* qa, const float* oa, const float* qb, const float* ob, const float* qc, const float* oc, int layer) {
    LayerW w; w.mixer = layer % 3; const int j = layer / 3;
    w.Nq = (w.mixer == 1) ? 1536 : 3 * D;
    w.wqkv = sel3(w.mixer, qa + (size_t)j * D * 3 * D, qb + (size_t)j * D * 1536, qc + (size_t)j * D * 3 * D);
    w.wo = sel3(w.mixer, oa + (size_t)j * D * D, ob + (size_t)j * D * D, oc + (size_t)j * D * D);
    return w;
}

__device__ __forceinline__ void phase_cvt(const LayerW lw, const float* x_in, const float* p_in, const float* weg, const float* weu, const float* wed, const float* wpg, const float* wpp, const float* wgrp, const float* wexp, unsigned char* ws, int layer, LAS unsigned char* lds, int gw, int NGW, int wave, int lane) {
    LAS float* scr = (LAS float*)(lds + wave * 8448);
    bf16_t* Wqkv_t = (bf16_t*)(ws + WS_WQKV); bf16_t* Wo_t = (bf16_t*)(ws + WS_WO); bf16_t* W1_t = (bf16_t*)(ws + WS_W1); bf16_t* W2_t = (bf16_t*)(ws + WS_W2);
    bf16_t* Wpg_t = (bf16_t*)(ws + WS_WPG); bf16_t* Wpp_t = (bf16_t*)(ws + WS_WPP);
    const int nqb = lw.Nq / 32, nq_items = 16 * nqb;
    const int total = nq_items + 512 + 3 * 8192 + 512 + 128;
    const float* wg = weg + (size_t)layer * NE * D * DE; const float* wu = weu + (size_t)layer * NE * D * DE; const float* wd = wed + (size_t)layer * NE * DE * D;
    for (int it = gw; it < total; it += NGW) {
        int r = it;
        if (r < nq_items) { const int kb = r / nqb, nb = r % nqb; transpose_item(lw.wqkv, lw.Nq, 64 * kb, 32 * nb, Wqkv_t + (size_t)(32 * nb) * D + 64 * kb, D, scr, lane); continue; } r -= nq_items;
        if (r < 512) { const int kb = r >> 5, nb = r & 31; transpose_item(lw.wo, D, 64 * kb, 32 * nb, Wo_t + (size_t)(32 * nb) * D + 64 * kb, D, scr, lane); continue; } r -= 512;
        if (r < 8192) { const int e = r >> 8, q = r & 255, kb = q >> 4, nb = q & 15, n0 = 32 * nb, row0 = 256 * (n0 >> 7) + (n0 & 127);
            transpose_item(wg + (size_t)e * D * DE, DE, 64 * kb, n0, W1_t + ((size_t)e * 1024 + row0) * D + 64 * kb, D, scr, lane); continue; } r -= 8192;
        if (r < 8192) { const int e = r >> 8, q = r & 255, kb = q >> 4, nb = q & 15, n0 = 32 * nb, row0 = 256 * (n0 >> 7) + 128 + (n0 & 127);
            transpose_item(wu + (size_t)e * D * DE, DE, 64 * kb, n0, W1_t + ((size_t)e * 1024 + row0) * D + 64 * kb, D, scr, lane); continue; } r -= 8192;
        if (r < 8192) { const int e = r >> 8, q = r & 255, kb = q >> 5, nb = q & 31;
            transpose_item(wd + (size_t)e * DE * D, D, 64 * kb, 32 * nb, W2_t + ((size_t)e * 1024 + 32 * nb) * DE + 64 * kb, DE, scr, lane); continue; } r -= 8192;
        if (r < 512) { const int kb = r >> 5, nb = r & 31; transpose_item(wpg + (size_t)layer * D * D, D, 64 * kb, 32 * nb, Wpg_t + (size_t)(32 * nb) * D + 64 * kb, D, scr, lane); continue; } r -= 512;
        { const int kb = r >> 5, nb = r & 31; transpose_item(wpp + (size_t)layer * PLE * D, D, 64 * kb, 32 * nb, Wpp_t + (size_t)(32 * nb) * PLE + 64 * kb, PLE, scr, lane); }
    }
    for (int it = gw * 64 + lane; it < 32 * 3 * 64; it += NGW * 64) {
        const int l64 = it & 63, kt = it >> 6, tile = kt % 3, ks = kt / 3, col = tile * 16 + (l64 & 15), k0 = 32 * ks + 8 * (l64 >> 4);
        float w[8];
#pragma unroll
        for (int j = 0; j < 8; ++j) w[j] = (col < 4) ? wgrp[(size_t)(k0 + j) * 4 + col] : ((col < 36) ? wexp[(size_t)(k0 + j) * 32 + (col - 4)] : 0.f);
        u32x4 h, lo; h.x = cvt_pk_bf16(w[0], w[1]); h.y = cvt_pk_bf16(w[2], w[3]); h.z = cvt_pk_bf16(w[4], w[5]); h.w = cvt_pk_bf16(w[6], w[7]);
        lo.x = cvt_pk_bf16(w[0] - __uint_as_float(h.x << 16), w[1] - __uint_as_float(h.x & 0xffff0000u)); lo.y = cvt_pk_bf16(w[2] - __uint_as_float(h.y << 16), w[3] - __uint_as_float(h.y & 0xffff0000u));
        lo.z = cvt_pk_bf16(w[4] - __uint_as_float(h.z << 16), w[5] - __uint_as_float(h.z & 0xffff0000u)); lo.w = cvt_pk_bf16(w[6] - __uint_as_float(h.w << 16), w[7] - __uint_as_float(h.w & 0xffff0000u));
        bf16_t* dst = (bf16_t*)(ws + WS_WRF) + (size_t)(kt * 2) * 512 + l64 * 8;
        *(u32x4*)dst = h; *(u32x4*)(dst + 512) = lo;
    }
    cvt_rows(p_in + (size_t)layer * M * PLE, (bf16_t*)(ws + WS_PB), (long)M * PLE / 512, gw, NGW, lane);
    if (layer == 0) cvt_rows(x_in, (bf16_t*)(ws + WS_XBA), (long)M * D / 512, gw, NGW, lane);
}

__device__ __forceinline__ void phase_kmean(const bf16_t* __restrict__ Kp, int ldk, float* __restrict__ kmean, LAS unsigned char* lds, int tid) {
    LAS float* red = (LAS float*)lds;
    for (int unit = blockIdx.x; unit < BATCH * 8; unit += gridDim.x) {
        const int b = unit >> 3, blk = unit & 7, cg = tid & 127, rg = tid >> 7;
        float s[8];
#pragma unroll
        for (int i = 0; i < 8; ++i) s[i] = 0.f;
        const bf16_t* p = Kp + (size_t)(b * SEQ + blk * 256 + rg * 64) * ldk + cg * 8;
        for (int r = 0; r < 64; ++r) { const u32x4 v = *(const u32x4*)(p + (size_t)r * ldk);
            s[0] += __uint_as_float(v.x << 16); s[1] += __uint_as_float(v.x & 0xffff0000u); s[2] += __uint_as_float(v.y << 16); s[3] += __uint_as_float(v.y & 0xffff0000u);
            s[4] += __uint_as_float(v.z << 16); s[5] += __uint_as_float(v.z & 0xffff0000u); s[6] += __uint_as_float(v.w << 16); s[7] += __uint_as_float(v.w & 0xffff0000u); }
        __syncthreads();
#pragma unroll
        for (int i = 0; i < 8; ++i) red[rg * 1024 + cg * 8 + i] = s[i];
        __syncthreads();
#pragma unroll
        for (int i = 0; i < 2; ++i) { const int c = tid * 2 + i; const float t = (red[c] + red[1024 + c]) + (red[2048 + c] + red[3072 + c]);
            kmean[(((size_t)(b * NH + (c >> 6)) * 8 + blk) * 64) + (c & 63)] = t * (1.f / 256.f); }
    }
    __syncthreads();
}

__device__ __forceinline__ void phase_ln1_route(const float* __restrict__ T, const float* __restrict__ g, const float* __restrict__ bb, float* X, bf16_t* __restrict__ xb,
                                                const bf16_t* __restrict__ Wrf, const float* __restrict__ bgrp, const float* __restrict__ bexp,
                                                int* __restrict__ cnt, int* __restrict__ list, TokInfo* __restrict__ ti, LAS unsigned char* lds, int wave, int lane, int gw, int NGW) {
    LAS float* lgs = (LAS float*)lds + wave * (16 * 52);
    f32x4 gg[4], b4[4];
#pragma unroll
    for (int j = 0; j < 4; ++j) { gg[j] = *(const f32x4*)(g + (j * 64 + lane) * 4); b4[j] = *(const f32x4*)(bb + (j * 64 + lane) * 4); }
    LAS int* hist = (LAS int*)(lds + 32768);
    for (int g0 = (int)blockIdx.x * NWAVES; g0 < M / 16; g0 += NGW) {
        const int gi = g0 + wave; const bool gval = gi < M / 16;
        const int row0 = (gval ? gi : 0) * 16;
        if (lane < 32 && wave == 0) hist[lane] = 0;
        if (gval) {
#pragma unroll 1
        for (int bt = 0; bt < 4; ++bt) {
            f32x4 v[4][4]; float s[4];
#pragma unroll
            for (int i = 0; i < 4; ++i) { const float* tr = T + (size_t)(row0 + bt * 4 + i) * D;
#pragma unroll
                for (int j = 0; j < 4; ++j) v[i][j] = *(const f32x4*)(tr + (j * 64 + lane) * 4); }
#pragma unroll
            for (int i = 0; i < 4; ++i) { s[i] = 0.f;
#pragma unroll
                for (int j = 0; j < 4; ++j) s[i] += (v[i][j][0] + v[i][j][1]) + (v[i][j][2] + v[i][j][3]); }
#pragma unroll
            for (int o = 1; o < 64; o <<= 1)
#pragma unroll
                for (int i = 0; i < 4; ++i) s[i] += __shfl_xor(s[i], o);
            float q[4];
#pragma unroll
            for (int i = 0; i < 4; ++i) { const float mu = s[i] * (1.f / D); q[i] = 0.f;
#pragma unroll
                for (int j = 0; j < 4; ++j) { v[i][j] = v[i][j] - mu; q[i] += (v[i][j][0] * v[i][j][0] + v[i][j][1] * v[i][j][1]) + (v[i][j][2] * v[i][j][2] + v[i][j][3] * v[i][j][3]); } }
#pragma unroll
            for (int o = 1; o < 64; o <<= 1)
#pragma unroll
                for (int i = 0; i < 4; ++i) q[i] += __shfl_xor(q[i], o);
#pragma unroll
            for (int i = 0; i < 4; ++i) { const float rstd = 1.f / sqrtf(q[i] * (1.f / D) + LN_EPS); const size_t ro = (size_t)(row0 + bt * 4 + i) * D;
#pragma unroll
                for (int j = 0; j < 4; ++j) { const int col = (j * 64 + lane) * 4; const f32x4 y = v[i][j] * rstd * gg[j] + b4[j];
                    *(f32x4*)(X + ro + col) = y;
                    u32x2 o; o.x = cvt_pk_bf16(y[0], y[1]); o.y = cvt_pk_bf16(y[2], y[3]); *(u32x2*)(xb + ro + col) = o; } }
        }
        asm volatile("s_waitcnt vmcnt(0)" ::: "memory");
        __builtin_amdgcn_fence(__ATOMIC_ACQUIRE, "agent");
        f32x4 acc[3];
#pragma unroll
        for (int t = 0; t < 3; ++t) acc[t] = (f32x4){0.f, 0.f, 0.f, 0.f};
        const float* xr = X + (size_t)(row0 + (lane & 15)) * D + 8 * (lane >> 4);
        const bf16_t* wf = Wrf + lane * 8;
#pragma unroll 2
        for (int ks = 0; ks < 32; ++ks) {
            const f32x4 a0 = *(const f32x4*)(xr + 32 * ks), a1 = *(const f32x4*)(xr + 32 * ks + 4);
            u32x4 h; h.x = cvt_pk_bf16(a0[0], a0[1]); h.y = cvt_pk_bf16(a0[2], a0[3]); h.z = cvt_pk_bf16(a1[0], a1[1]); h.w = cvt_pk_bf16(a1[2], a1[3]);
            u32x4 lo;
            lo.x = cvt_pk_bf16(a0[0] - __uint_as_float(h.x << 16), a0[1] - __uint_as_float(h.x & 0xffff0000u)); lo.y = cvt_pk_bf16(a0[2] - __uint_as_float(h.y << 16), a0[3] - __uint_as_float(h.y & 0xffff0000u));
            lo.z = cvt_pk_bf16(a1[0] - __uint_as_float(h.z << 16), a1[1] - __uint_as_float(h.z & 0xffff0000u)); lo.w = cvt_pk_bf16(a1[2] - __uint_as_float(h.w << 16), a1[3] - __uint_as_float(h.w & 0xffff0000u));
            const bf16x8 xh = __builtin_bit_cast(bf16x8, h), xl = __builtin_bit_cast(bf16x8, lo);
#pragma unroll
            for (int t = 0; t < 3; ++t) { const bf16x8 wh = *(const bf16x8*)(wf + (size_t)((ks * 3 + t) * 2 + 0) * 512), wl = *(const bf16x8*)(wf + (size_t)((ks * 3 + t) * 2 + 1) * 512);
                acc[t] = __builtin_amdgcn_mfma_f32_16x16x32_bf16(xh, wh, acc[t], 0, 0, 0); acc[t] = __builtin_amdgcn_mfma_f32_16x16x32_bf16(xl, wh, acc[t], 0, 0, 0); acc[t] = __builtin_amdgcn_mfma_f32_16x16x32_bf16(xh, wl, acc[t], 0, 0, 0); }
        }
#pragma unroll
        for (int t = 0; t < 3; ++t)
#pragma unroll
            for (int j = 0; j < 4; ++j) lgs[(4 * (lane >> 4) + j) * 52 + t * 16 + (lane & 15)] = acc[t][j];
        asm volatile("s_waitcnt lgkmcnt(0)" ::: "memory");
        }
        int e0 = 0, e1 = 0, r0 = 0, r1 = 0; float w0 = 0.f, w1 = 0.f;
        __syncthreads();
        if (gval && lane < 16) {
            float lg[36];
#pragma unroll
            for (int c4 = 0; c4 < 9; ++c4) { const f32x4 w = *(const LAS f32x4*)(lgs + lane * 52 + 4 * c4); lg[4 * c4] = w[0]; lg[4 * c4 + 1] = w[1]; lg[4 * c4 + 2] = w[2]; lg[4 * c4 + 3] = w[3]; }
            float gl[4];
#pragma unroll
            for (int c = 0; c < 4; ++c) gl[c] = lg[c] + bgrp[c];
            int gi_ = 0; float gm = gl[0];
#pragma unroll
            for (int c = 1; c < 4; ++c) if (gl[c] > gm) { gm = gl[c]; gi_ = c; }
            float gs = 0.f;
#pragma unroll
            for (int c = 0; c < 4; ++c) gs += __expf(gl[c] - gm);
            const float gp = 1.f / gs;
            float el[8];
#pragma unroll
            for (int c = 0; c < 8; ++c) { float t = lg[4 + c];
#pragma unroll
                for (int gq = 1; gq < 4; ++gq) t = (gi_ == gq) ? lg[4 + gq * 8 + c] : t;
                el[c] = t + bexp[gi_ * 8 + c]; }
            int i0 = 0; float m0 = el[0];
#pragma unroll
            for (int c = 1; c < 8; ++c) if (el[c] > m0) { m0 = el[c]; i0 = c; }
            int i1 = -1; float m1 = -INFINITY;
#pragma unroll
            for (int c = 0; c < 8; ++c) if (c != i0 && el[c] > m1) { m1 = el[c]; i1 = c; }
            const float p1 = __expf(m1 - m0);
            w0 = gp / (1.f + p1); w1 = gp * p1 / (1.f + p1);
            e0 = gi_ * 8 + i0; e1 = gi_ * 8 + i1;
            r0 = __hip_atomic_fetch_add(&hist[e0], 1, __ATOMIC_RELAXED, __HIP_MEMORY_SCOPE_WORKGROUP); r1 = __hip_atomic_fetch_add(&hist[e1], 1, __ATOMIC_RELAXED, __HIP_MEMORY_SCOPE_WORKGROUP);
        }
        __syncthreads();
        if (wave == 0 && lane < 32) { const int n = hist[lane]; hist[32 + lane] = n ? atomicAdd(&cnt[lane * 32], n) : 0; }
        __syncthreads();
        if (gval && lane < 16) {
            const int row = row0 + lane, q0 = hist[32 + e0] + r0, q1 = hist[32 + e1] + r1;
            list[(size_t)e0 * M + q0] = row; list[(size_t)e1 * M + q1] = row;
            TokInfo t; t.e0 = e0; t.p0 = q0; t.e1 = e1; t.p1 = q1; t.g0 = w0; t.g1 = w1; t.pad0 = 0; t.pad1 = 0;
            ti[row] = t;
        }
        __syncthreads();
    }
}

__device__ __forceinline__ void moe_tables(const int* __restrict__ cnt, LAS int* tbl, int tid) {
    __syncthreads();
    if (tid < 32) tbl[33 + tid] = cnt[tid * 32];
    __syncthreads();
    if (tid == 0) { int acc = 0; for (int e = 0; e < 32; ++e) { tbl[e] = acc; acc += (tbl[33 + e] + 255) >> 8; } tbl[32] = acc; }
    __syncthreads();
}

__device__ __forceinline__ void phase_ln2(const float* Xin, float* X, const bf16_t* __restrict__ Y, const TokInfo* __restrict__ ti, LAS const int* tbl, const float* __restrict__ g, const float* __restrict__ bb,
                                          bf16_t* __restrict__ xb, int gw, int NGW, int lane) {
    for (int row = gw; row < M; row += NGW) {
        const TokInfo t = ti[row];
        const bf16_t* y0 = Y + ((size_t)tbl[t.e0] * 256 + t.p0) * D; const bf16_t* y1 = Y + ((size_t)tbl[t.e1] * 256 + t.p1) * D;
        f32x4 v[4]; float s = 0.f;
#pragma unroll
        for (int j = 0; j < 4; ++j) { const int col = (j * 64 + lane) * 4; const f32x4 xv = *(const f32x4*)(Xin + (size_t)row * D + col);
            const u32x2 a = *(const u32x2*)(y0 + col), b = *(const u32x2*)(y1 + col);
            f32x4 ya, yb; ya[0] = __uint_as_float(a.x << 16); ya[1] = __uint_as_float(a.x & 0xffff0000u); ya[2] = __uint_as_float(a.y << 16); ya[3] = __uint_as_float(a.y & 0xffff0000u);
            yb[0] = __uint_as_float(b.x << 16); yb[1] = __uint_as_float(b.x & 0xffff0000u); yb[2] = __uint_as_float(b.y << 16); yb[3] = __uint_as_float(b.y & 0xffff0000u);
            v[j] = xv * ALPHA + (ya * t.g0 + yb * t.g1); s += (v[j][0] + v[j][1]) + (v[j][2] + v[j][3]); }
        const float mu = wave_sum(s) * (1.f / D); float q = 0.f;
#pragma unroll
        for (int j = 0; j < 4; ++j) { v[j] = v[j] - mu; q += (v[j][0] * v[j][0] + v[j][1] * v[j][1]) + (v[j][2] * v[j][2] + v[j][3] * v[j][3]); }
        const float rstd = 1.f / sqrtf(wave_sum(q) * (1.f / D) + LN_EPS);
#pragma unroll
        for (int j = 0; j < 4; ++j) { const int col = (j * 64 + lane) * 4; const f32x4 gg = *(const f32x4*)(g + col), b4 = *(const f32x4*)(bb + col);
            v[j] = v[j] * rstd * gg + b4;
            *(f32x4*)(X + (size_t)row * D + col) = v[j];
            u32x2 o; o.x = cvt_pk_bf16(v[j][0], v[j][1]); o.y = cvt_pk_bf16(v[j][2], v[j][3]); *(u32x2*)(xb + (size_t)row * D + col) = o; }
    }
}

template <int MODE>
__global__ __launch_bounds__(256) void k_attn(const bf16_t* __restrict__ Q, int ldq, const bf16_t* __restrict__ Kp, const bf16_t* __restrict__ Vp, int ldkv, int kvdiv,
                                               bf16_t* __restrict__ O, const float* __restrict__ kmean, const float* __restrict__ sinks, float qscale)
{
    __shared__ float Ks[64][64];
    __shared__ float Vs[64][64];
    const int c = blockIdx.x, h = blockIdx.y, b = blockIdx.z, tid = threadIdx.x;
    const int t = c * 256 + tid;
    const float slope = exp2f(-8.0f * (float)(h + 1) / 16.0f);
    float q[64], o[64];
    {
        const bf16_t* qp = Q + (size_t)(b * SEQ + t) * ldq + h * 64;
#pragma unroll
        for (int d = 0; d < 64; ++d) q[d] = bf2f(qp[d]) * qscale;
    }
#pragma unroll
    for (int d = 0; d < 64; ++d) o[d] = 0.f;
    unsigned selmask = 0;
    if (MODE == 0) {
        float g[8];
#pragma unroll
        for (int n = 0; n < 8; ++n) {
            float s = 0.f;
            if (n < c) {
                const float* km = kmean + (((size_t)(b * NH + h) * 8 + n) * 64);
#pragma unroll
                for (int d = 0; d < 64; ++d) s = fmaf(q[d], km[d], s);
            }
            g[n] = s;
        }
#pragma unroll
        for (int r = 0; r < 3; ++r) {
            float best = -INFINITY; int bi = -1;
#pragma unroll
            for (int n = 0; n < 8; ++n) { const bool cand = (n < c) && !((selmask >> n) & 1u) && (g[n] > best); if (cand) { best = g[n]; bi = n; } }
            if (bi >= 0) selmask |= 1u << bi;
        }
    }
    float m = -INFINITY, l = 0.f, after = 0.f;
    if (MODE == 1) { m = sinks[h]; l = 1.f; }
    int tile_lo, tile_hi;
    if (MODE == 0) { tile_lo = 0; tile_hi = 4 * c + 3; }
    else if (MODE == 1) { tile_lo = 4 * c - 2 < 0 ? 0 : 4 * c - 2; tile_hi = 4 * c + 3; }
    else { tile_lo = 0; tile_hi = 4 * c + 3; }
    const int kvh = h / kvdiv;
    for (int it = 0; it <= tile_hi - tile_lo; ++it) {
        const int tile = (MODE == 2) ? (tile_hi - it) : (tile_lo + it);
        __syncthreads();
#pragma unroll
        for (int i = 0; i < 4; ++i) {
            const int e = (i * 256 + tid) * 4, r = e >> 6, d = e & 63;
            const size_t off = (size_t)(b * SEQ + tile * 64 + r) * ldkv + kvh * 64 + d;
            const u32x2 kk = *(const u32x2*)(Kp + off), vv = *(const u32x2*)(Vp + off);
            Ks[r][d] = __uint_as_float(kk.x << 16); Ks[r][d + 1] = __uint_as_float(kk.x & 0xffff0000u); Ks[r][d + 2] = __uint_as_float(kk.y << 16); Ks[r][d + 3] = __uint_as_float(kk.y & 0xffff0000u);
            Vs[r][d] = __uint_as_float(vv.x << 16); Vs[r][d + 1] = __uint_as_float(vv.x & 0xffff0000u); Vs[r][d + 2] = __uint_as_float(vv.y << 16); Vs[r][d + 3] = __uint_as_float(vv.y & 0xffff0000u);
        }
        __syncthreads();
        for (int jj = 0; jj < 64; ++jj) {
            const int j = (MODE == 2) ? (63 - jj) : jj;
            const int s = tile * 64 + j;
            bool valid;
            if (MODE == 0) { const int n = tile >> 2; valid = (n == c) ? (s <= t) : (((selmask >> n) & 1u) != 0u); }
            else if (MODE == 1) { valid = (t - s >= 0) && (t - s < 128); }
            else { valid = s < t; }
            if (valid) {
                float dot = 0.f;
#pragma unroll
                for (int d = 0; d < 64; d += 4) { const float4 kk = *(const float4*)&Ks[j][d]; dot = fmaf(q[d], kk.x, dot); dot = fmaf(q[d + 1], kk.y, dot); dot = fmaf(q[d + 2], kk.z, dot); dot = fmaf(q[d + 3], kk.w, dot); }
                float p;
                if (MODE == 2) {
                    const float z = dot * 0.125f;
                    const float sp = fmaxf(z, 0.f) + log1pf(expf(-fabsf(z)));
                    p = expf(z - sp + after);
                    after -= sp;
                } else {
                    const float lg = dot * 0.125f - slope * (float)(t - s);
                    if (lg > m) { const float cs = expf(m - lg); l *= cs;
#pragma unroll
                        for (int d = 0; d < 64; ++d) o[d] *= cs;
                        m = lg; }
                    p = expf(lg - m); l += p;
                }
#pragma unroll
                for (int d = 0; d < 64; d += 4) { const float4 vv = *(const float4*)&Vs[j][d]; o[d] = fmaf(p, vv.x, o[d]); o[d + 1] = fmaf(p, vv.y, o[d + 1]); o[d + 2] = fmaf(p, vv.z, o[d + 2]); o[d + 3] = fmaf(p, vv.w, o[d + 3]); }
            }
        }
    }
    const float inv = (MODE == 2) ? 1.f : 1.f / l;
    bf16_t* op = O + (size_t)(b * SEQ + t) * D + h * 64;
#pragma unroll
    for (int d = 0; d < 64; d += 2) *(unsigned*)(op + d) = cvt_pk_bf16(o[d] * inv, o[d + 1] * inv);
}

namespace att {
typedef float f32x16 __attribute__((ext_vector_type(16)));
typedef _Float16 half8 __attribute__((ext_vector_type(8)));
typedef _Float16 half2v __attribute__((ext_vector_type(2)));
typedef short v4i16 __attribute__((ext_vector_type(4)));
constexpr int SLOTB = 8192, NSL = 3;
constexpr int L_K = 0, L_V = NSL * SLOTB, L_WS = 2 * NSL * SLOTB, L_OST = L_WS + 2048, L_KM = L_OST + 8 * 4096, L_FLAG = L_KM + 2048, L_END = L_FLAG + 64;
static_assert(L_END <= RING_BYTES, "attention LDS");

__device__ __forceinline__ int crow(int r, int hi) { return (r & 3) + 8 * (r >> 2) + 4 * hi; }
__device__ __forceinline__ float swap_max(float m) { auto rr = __builtin_amdgcn_permlane32_swap(__float_as_uint(m), __float_as_uint(m), false, false); return fmaxf(__uint_as_float(rr[0]), __uint_as_float(rr[1])); }
__device__ __forceinline__ float swap_sum(float m) { auto rr = __builtin_amdgcn_permlane32_swap(__float_as_uint(m), __float_as_uint(m), false, false); return __uint_as_float(rr[0]) + __uint_as_float(rr[1]); }
__device__ __forceinline__ v4i16 vtr(const LAS unsigned char* p) { return __builtin_amdgcn_ds_read_tr16_b64_v4i16((LAS v4i16*)p); }
__device__ __forceinline__ bf16x8 pack8(float a0, float a1, float a2, float a3, float a4, float a5, float a6, float a7) {
    u32x4 w; w.x = cvt_pk_bf16(a0, a1); w.y = cvt_pk_bf16(a2, a3); w.z = cvt_pk_bf16(a4, a5); w.w = cvt_pk_bf16(a6, a7); return __builtin_bit_cast(bf16x8, w); }
__device__ __forceinline__ half8 pack8h(float a0, float a1, float a2, float a3, float a4, float a5, float a6, float a7) {
    const half2v h0 = __builtin_convertvector((f32x2){a0, a1}, half2v), h1 = __builtin_convertvector((f32x2){a2, a3}, half2v), h2 = __builtin_convertvector((f32x2){a4, a5}, half2v), h3 = __builtin_convertvector((f32x2){a6, a7}, half2v);
    return (half8){h0[0], h0[1], h1[0], h1[1], h2[0], h2[1], h3[0], h3[1]}; }

template <int MODE>
__device__ __forceinline__ void attn_unit(const bf16_t* __restrict__ Qg, const bf16_t* __restrict__ Kg, const bf16_t* __restrict__ Vg, const int pitch, bf16_t* __restrict__ Og,
                                          const int c, const float slope2, const float sink2, const float* __restrict__ kmean_bh, LAS unsigned char* shm, const int wid, const int lane) {
    const int r32 = lane & 31, hi = lane >> 5;
    const int q0 = c * 256, qw0 = q0 + wid * 32, tq = qw0 + r32;
    const int tmax = 4 * c + 3, tmin = (MODE == 1) ? ((4 * c - 2 < 0) ? 0 : 4 * c - 2) : 0;
    const int NT = tmax - tmin + 1;
    LAS float* wsf = (LAS float*)(shm + L_WS) + wid * 64;
    const bf16_t* ksrc = Kg + (size_t)lane * pitch + wid * 8;
    const bf16_t* vsrc = Vg + (size_t)(16 * (wid & 3) + (lane >> 2)) * pitch + (wid >> 2) * 32 + (lane & 3) * 8;
#define ATT_PT(i) ((MODE == 2) ? (tmax - (i)) : (tmin + (i)))
#define ATT_DMA(i, slot) do { const size_t off_ = (size_t)ATT_PT(i) * 64 * pitch; \
        __builtin_amdgcn_global_load_lds((const unsigned*)(ksrc + off_), (LAS unsigned*)(shm + L_K + (slot) + wid * 1024), 16, 0, 0); \
        __builtin_amdgcn_global_load_lds((const unsigned*)(vsrc + off_), (LAS unsigned*)(shm + L_V + (slot) + wid * 1024), 16, 0, 0); } while (0)
    ATT_DMA(0, 0);
    if (NT > 1) ATT_DMA(1, SLOTB);
    bf16x8 qr[4];
    { const bf16_t* Qw = Qg + (size_t)tq * pitch;
#pragma unroll
      for (int d0 = 0; d0 < 4; ++d0) qr[d0] = *(const bf16x8*)(Qw + d0 * 16 + hi * 8); }
    unsigned selmask = 0u;
    if (MODE == 0) {
        LAS float* km = (LAS float*)(shm + L_KM);
        km[wid * 64 + lane] = kmean_bh[wid * 64 + lane];
        asm volatile("s_waitcnt vmcnt(0) lgkmcnt(0)" ::: "memory"); __builtin_amdgcn_s_barrier(); asm volatile("" ::: "memory");
        float g[8];
#pragma unroll
        for (int n = 0; n < 8; ++n) {
            float s = 0.f;
            if (n < c) {
#pragma unroll
                for (int d0 = 0; d0 < 4; ++d0) {
                    const f32x4 k0 = *(const LAS f32x4*)(km + n * 64 + 16 * d0 + 8 * hi), k1 = *(const LAS f32x4*)(km + n * 64 + 16 * d0 + 8 * hi + 4);
                    const u32x4 qq = __builtin_bit_cast(u32x4, qr[d0]);
                    s = fmaf(__uint_as_float(qq.x << 16), k0[0], s); s = fmaf(__uint_as_float(qq.x & 0xffff0000u), k0[1], s);
                    s = fmaf(__uint_as_float(qq.y << 16), k0[2], s); s = fmaf(__uint_as_float(qq.y & 0xffff0000u), k0[3], s);
                    s = fmaf(__uint_as_float(qq.z << 16), k1[0], s); s = fmaf(__uint_as_float(qq.z & 0xffff0000u), k1[1], s);
                    s = fmaf(__uint_as_float(qq.w << 16), k1[2], s); s = fmaf(__uint_as_float(qq.w & 0xffff0000u), k1[3], s);
                }
                s = swap_sum(s);
            }
            g[n] = s;
        }
#pragma unroll
        for (int rr = 0; rr < 3; ++rr) {
            float best = -INFINITY; int bi = -1;
#pragma unroll
            for (int n = 0; n < 8; ++n) { const bool cand = (n < c) && !((selmask >> n) & 1u) && (g[n] > best); if (cand) { best = g[n]; bi = n; } }
            if (bi >= 0) selmask |= 1u << bi;
        }
    }
    f32x16 o0 = {}, o1 = {};
    float mhat = (MODE == 1) ? sink2 : -1e30f;
    float l = (MODE == 1 && hi == 0) ? 1.f : 0.f;
    float carry = 0.f;
    half8 T0a, T0b, TONE;
    if (MODE == 2) {
#pragma unroll
        for (int j = 0; j < 8; ++j) { const int ks = (j & 3) + 8 * (j >> 2) + 4 * hi;
            T0a[j] = (ks > r32) ? (_Float16)1.0f : (_Float16)0.0f; T0b[j] = (16 + ks > r32) ? (_Float16)1.0f : (_Float16)0.0f; TONE[j] = (_Float16)1.0f; }
    }
    int slot = 0, slot2 = (2 % NSL) * SLOTB;
    for (int i = 0; i < NT; ++i) {
        if (i + 1 < NT) asm volatile("s_waitcnt vmcnt(2) lgkmcnt(0)" ::: "memory"); else asm volatile("s_waitcnt vmcnt(0) lgkmcnt(0)" ::: "memory");
        __builtin_amdgcn_s_barrier(); asm volatile("" ::: "memory");
        if (MODE == 2 && i > 0) {
            const LAS unsigned* fl = (const LAS unsigned*)(shm + L_FLAG) + ((i - 1) & 1) * 8;
            const u32x4 fa = *(const LAS u32x4*)fl, fb = *(const LAS u32x4*)(fl + 4);
            if ((fa.x & fa.y & fa.z & fa.w & fb.x & fb.y & fb.z & fb.w) != 0u) break;
        }
        if (i + 2 < NT) ATT_DMA(i + 2, slot2);
        const int pt = ATT_PT(i), kbase = pt * 64;
        bool need;
        if (MODE == 0) { const int n = pt >> 2; need = (n == c) ? (kbase <= qw0 + 31) : (__any((int)((selmask >> n) & 1u)) != 0); }
        else if (MODE == 1) need = (kbase <= qw0 + 31) && (kbase + 63 >= qw0 - 127);
        else need = (kbase < qw0 + 31);
        if (need) {
            f32x16 p0 = {}, p1 = {};
            { const LAS unsigned char* kb = shm + L_K + slot + hi * 1024 + r32 * 16;
#pragma unroll
              for (int d0 = 0; d0 < 4; ++d0) { const bf16x8 b0 = *(const LAS bf16x8*)(kb + d0 * 2048), b1 = *(const LAS bf16x8*)(kb + d0 * 2048 + 512);
                  p0 = __builtin_amdgcn_mfma_f32_32x32x16_bf16(b0, qr[d0], p0, 0, 0, 0); p1 = __builtin_amdgcn_mfma_f32_32x32x16_bf16(b1, qr[d0], p1, 0, 0, 0); } }
            bf16x8 pw0, pw1, pw2, pw3;
            if (MODE != 2) {
                const float at = slope2 * (float)(kbase + 4 * hi - tq), s32 = 32.f * slope2;
                const int dq = tq - kbase - 4 * hi;
                const bool selb = (MODE == 0) ? (((selmask >> (pt >> 2)) & 1u) != 0u) : true;
                const bool own = (MODE == 0) ? ((pt >> 2) == c) : true;
#pragma unroll
                for (int r = 0; r < 16; ++r) { const int kr = (r & 3) + 8 * (r >> 2); const float bb = fmaf(slope2, (float)kr, at);
                    const int d0_ = dq - kr, d1_ = d0_ - 32;
                    bool v0, v1;
                    if (MODE == 0) { v0 = own ? (d0_ >= 0) : selb; v1 = own ? (d1_ >= 0) : selb; }
                    else { v0 = (d0_ >= 0) && (d0_ < 128); v1 = (d1_ >= 0) && (d1_ < 128); }
                    p0[r] = v0 ? (p0[r] + bb) : -INFINITY; p1[r] = v1 ? (p1[r] + (bb + s32)) : -INFINITY; }
                float rm = fmaxf(p0[0], p1[0]);
#pragma unroll
                for (int r = 1; r < 16; ++r) rm = fmaxf(rm, fmaxf(p0[r], p1[r]));
                rm = swap_max(rm);
                if (__any((int)(rm > mhat + 8.f))) {
                    const float mnew = fmaxf(mhat, rm), f = __builtin_amdgcn_exp2f(mhat - mnew);
                    mhat = mnew; l *= f;
                    if (hi == 0) wsf[r32] = f;
                    asm volatile("s_waitcnt lgkmcnt(0)" ::: "memory");
#pragma unroll
                    for (int r = 0; r < 16; ++r) { const float fr_ = wsf[crow(r, hi)]; o0[r] *= fr_; o1[r] *= fr_; }
                }
                float sacc = 0.f;
#pragma unroll
                for (int r = 0; r < 16; ++r) { p0[r] = __builtin_amdgcn_exp2f(p0[r] - mhat); p1[r] = __builtin_amdgcn_exp2f(p1[r] - mhat); sacc += p0[r] + p1[r]; }
                l += sacc;
            } else {
                f32x16 lk0, lk1;
                const int dq = tq - kbase - 4 * hi;
                float tsum = 0.f;
#pragma unroll
                for (int r = 0; r < 16; ++r) { const int kr = (r & 3) + 8 * (r >> 2);
                    const bool v0 = (dq - kr) > 0, v1 = (dq - kr - 32) > 0;
                    { const float z = p0[r], e = __builtin_amdgcn_exp2f(-fabsf(z)), sp = fmaxf(z, 0.f) + __builtin_amdgcn_logf(1.f + e); lk0[r] = v0 ? -sp : 0.f; }
                    { const float z = p1[r], e = __builtin_amdgcn_exp2f(-fabsf(z)), sp = fmaxf(z, 0.f) + __builtin_amdgcn_logf(1.f + e); lk1[r] = v1 ? -sp : 0.f; }
                    tsum += lk0[r] + lk1[r]; }
                tsum = swap_sum(tsum);
                const half8 L0 = pack8h(lk0[0], lk0[1], lk0[2], lk0[3], lk0[4], lk0[5], lk0[6], lk0[7]), L1 = pack8h(lk0[8], lk0[9], lk0[10], lk0[11], lk0[12], lk0[13], lk0[14], lk0[15]);
                const half8 L2 = pack8h(lk1[0], lk1[1], lk1[2], lk1[3], lk1[4], lk1[5], lk1[6], lk1[7]), L3 = pack8h(lk1[8], lk1[9], lk1[10], lk1[11], lk1[12], lk1[13], lk1[14], lk1[15]);
                f32x16 c0 = {}, c1 = {};
                c0 = __builtin_amdgcn_mfma_f32_32x32x16_f16(T0a, L0, c0, 0, 0, 0); c0 = __builtin_amdgcn_mfma_f32_32x32x16_f16(T0b, L1, c0, 0, 0, 0);
                c0 = __builtin_amdgcn_mfma_f32_32x32x16_f16(TONE, L2, c0, 0, 0, 0); c0 = __builtin_amdgcn_mfma_f32_32x32x16_f16(TONE, L3, c0, 0, 0, 0);
                c1 = __builtin_amdgcn_mfma_f32_32x32x16_f16(T0a, L2, c1, 0, 0, 0); c1 = __builtin_amdgcn_mfma_f32_32x32x16_f16(T0b, L3, c1, 0, 0, 0);
#pragma unroll
                for (int r = 0; r < 16; ++r) { const int kr = (r & 3) + 8 * (r >> 2);
                    const bool v0 = (dq - kr) > 0, v1 = (dq - kr - 32) > 0;
                    p0[r] = v0 ? __builtin_amdgcn_exp2f(p0[r] + lk0[r] + (carry + c0[r])) : 0.f;
                    p1[r] = v1 ? __builtin_amdgcn_exp2f(p1[r] + lk1[r] + (carry + c1[r])) : 0.f; }
                carry += tsum;
            }
            pw0 = pack8(p0[0], p0[1], p0[2], p0[3], p0[4], p0[5], p0[6], p0[7]); pw1 = pack8(p0[8], p0[9], p0[10], p0[11], p0[12], p0[13], p0[14], p0[15]);
            pw2 = pack8(p1[0], p1[1], p1[2], p1[3], p1[4], p1[5], p1[6], p1[7]); pw3 = pack8(p1[8], p1[9], p1[10], p1[11], p1[12], p1[13], p1[14], p1[15]);
            { const LAS unsigned char* vp = shm + L_V + slot + ((lane >> 4) & 1) * 32 + (lane & 3) * 8 + (4 * hi + ((lane & 15) >> 2)) * 64;
#define ATT_PV(od, d0, ks, pw) do { const v4i16 lo_ = vtr(vp + (d0) * 4096 + (ks) * 1024), hh_ = vtr(vp + (d0) * 4096 + (ks) * 1024 + 512); \
                  const bf16x8 vf_ = (bf16x8){lo_[0], lo_[1], lo_[2], lo_[3], hh_[0], hh_[1], hh_[2], hh_[3]}; od = __builtin_amdgcn_mfma_f32_32x32x16_bf16(pw, vf_, od, 0, 0, 0); } while (0)
              ATT_PV(o0, 0, 0, pw0); ATT_PV(o1, 1, 0, pw0); ATT_PV(o0, 0, 1, pw1); ATT_PV(o1, 1, 1, pw1);
              ATT_PV(o0, 0, 2, pw2); ATT_PV(o1, 1, 2, pw2); ATT_PV(o0, 0, 3, pw3); ATT_PV(o1, 1, 3, pw3);
#undef ATT_PV
            }
        }
        if (MODE == 2) { const bool done = __all((int)(carry < -150.f)) != 0; if (lane == 0) ((LAS unsigned*)(shm + L_FLAG))[(i & 1) * 8 + wid] = done ? 1u : 0u; }
        slot = (slot == (NSL - 1) * SLOTB) ? 0 : slot + SLOTB; slot2 = (slot2 == (NSL - 1) * SLOTB) ? 0 : slot2 + SLOTB;
    }
    if (MODE != 2) l = swap_sum(l);
    if (hi == 0) wsf[r32] = (MODE == 2) ? 1.f : __builtin_amdgcn_rcpf(l);
    asm volatile("s_waitcnt lgkmcnt(0)" ::: "memory");
    { LAS bf16_t* stg = (LAS bf16_t*)(shm + L_OST) + wid * 2048;
#pragma unroll
      for (int r = 0; r < 16; ++r) { const int orow = crow(r, hi); const float rl = wsf[orow];
          stg[orow * 64 + r32] = (bf16_t)(cvt_pk_bf16(o0[r] * rl, 0.f) & 0xffffu); stg[orow * 64 + 32 + r32] = (bf16_t)(cvt_pk_bf16(o1[r] * rl, 0.f) & 0xffffu); }
      asm volatile("s_waitcnt lgkmcnt(0)" ::: "memory");
      bf16_t* Ow = Og + (size_t)qw0 * D;
#pragma unroll
      for (int i = 0; i < 4; ++i) { const int row = i * 8 + (lane >> 3), ch = lane & 7; const u32x4 v = *(const LAS u32x4*)(stg + row * 64 + ch * 8); *(u32x4*)(Ow + (size_t)row * D + ch * 8) = v; } }
    asm volatile("s_waitcnt vmcnt(0) lgkmcnt(0)" ::: "memory"); __builtin_amdgcn_s_barrier(); asm volatile("" ::: "memory");
#undef ATT_PT
#undef ATT_DMA
}

template <int MODE>
__device__ __forceinline__ void attn_phase(const bf16_t* __restrict__ QKV, const int pitch, const int kcol, const int vcol, const int kvdiv, bf16_t* __restrict__ O,
                                           const float* __restrict__ kmean, const float* __restrict__ sinks, LAS unsigned char* shm, const int wave0) {
    int lane_ = (int)__builtin_amdgcn_mbcnt_hi(~0u, __builtin_amdgcn_mbcnt_lo(~0u, 0u)); asm volatile("" : "+v"(lane_));
    const int lane = lane_, wid = wave0;
    for (int u = blockIdx.x; u < BATCH * NH * 8; u += gridDim.x) {
        const int bh = u & 255, c = u >> 8, b = bh >> 4, h = bh & 15;
        const float slope2 = exp2f(-0.5f * (float)(h + 1)) * LOG2E;
        const float sink2 = (MODE == 1) ? sinks[h] * LOG2E : 0.f;
        const bf16_t* base = QKV + (size_t)b * SEQ * pitch;
        attn_unit<MODE>(base + h * 64, base + kcol + (h / kvdiv) * 64, base + vcol + (h / kvdiv) * 64, pitch, O + (size_t)b * SEQ * D + h * 64, c, slope2, sink2,
                        (MODE == 0) ? (kmean + (size_t)bh * 512) : kmean, shm, wid, lane);
    }
}
}

struct KCtx { LAS unsigned char* lds; LAS int* tbl; unsigned char* ws; unsigned* ctl; int lo, hi, G, NGW, wave0; };
template <int layer>
__device__ __forceinline__ void run_layer(const Args& args, const KCtx& kc, const XcdBarrier& bar) {
    LAS unsigned char* lds = kc.lds; LAS int* tbl = kc.tbl; unsigned char* ws = kc.ws; unsigned* ctl = kc.ctl;
    const int lo = kc.lo, hi = kc.hi, G = kc.G, NGW = kc.NGW, wave0 = kc.wave0;
#define IN(k) (lo <= (k) && (k) < hi)
#define SEAM(k) do { if ((k) + 1 < hi) { xcd_barrier(bar); if (REPS(10) > 1) xcd_barrier(bar); } } while (0)
    float* X = (float*)(ws + WS_X);
    bf16_t* QKV = (bf16_t*)(ws + WS_QKV); bf16_t* Ob = (bf16_t*)(ws + WS_O); float* T = (float*)(ws + WS_T);
    bf16_t* Hb = (bf16_t*)(ws + WS_H); bf16_t* Yb = (bf16_t*)(ws + WS_Y); bf16_t* PP = (bf16_t*)(ws + WS_PP); bf16_t* PB = (bf16_t*)(ws + WS_PB);
    TokInfo* ti = (TokInfo*)(ws + WS_TI); int* list = (int*)(ws + WS_LIST); float* kmean = (float*)(ws + WS_KMEAN);
    {

        const int base = layer * NPH;
#define OPQ() int lane_ = __builtin_amdgcn_mbcnt_hi(~0u, __builtin_amdgcn_mbcnt_lo(~0u, 0u)); asm volatile("" : "+v"(lane_)); const int lane = lane_, wave = wave0, tid = wave0 * 64 + lane, gw = blockIdx.x * NWAVES + wave
        if (base + NPH <= lo || base >= hi) return;
        const LayerW lw = layer_weights(args.in[2], args.in[3], args.in[4], args.in[5], args.in[7], args.in[8], layer);
        bf16_t* xb_cur = (bf16_t*)(ws + ((layer & 1) ? WS_XBB : WS_XBA));
        bf16_t* xb_oth = (bf16_t*)(ws + ((layer & 1) ? WS_XBA : WS_XBB));
        const float* xres = (layer == 0) ? args.in[0] : X;
        int* cnt = (int*)(ctl + CW_CNT) + layer * 1024;

        if (IN(base + 0)) { for (int rep = 0; rep < REPS(0); ++rep) { OPQ(); phase_cvt(lw, args.in[0], args.in[1], args.in[17], args.in[18], args.in[19], args.in[20], args.in[21], args.in[13] + (size_t)layer * D * 4, args.in[15] + (size_t)layer * D * 32, ws, layer, lds, gw, NGW, wave, lane); } SEAM(base + 0); }

        if (IN(base + 1)) {
            for (int rep = 0; rep < REPS(1); ++rep) {
            { pg8::DenseOrder S; S.init(xb_cur, (const bf16_t*)(ws + WS_WQKV), M, lw.Nq, D, G, (int)blockIdx.x);
              pg8::EpiStoreBf16 E{QKV, lw.Nq, 0.125f * LOG2E, D};
              pg8::gemm_phase<pg8::EpiStoreBf16, pg8::DenseOrder, true, false>(lds, D, S, E, wave0); }
            { pg8::DenseOrder S; S.init(PB, (const bf16_t*)(ws + WS_WPP), M, D, PLE, G, (int)blockIdx.x);
              pg8::EpiStoreBf16 E{PP, D, 1.f, 0};
              pg8::gemm_phase<pg8::EpiStoreBf16, pg8::DenseOrder, true, false>(lds, PLE, S, E, wave0); }
            }
            SEAM(base + 1);
        }
        if (IN(base + 2)) { OPQ(); (void)lane; (void)gw; if (lw.mixer == 0) phase_kmean(QKV + D, lw.Nq, kmean, lds, tid); SEAM(base + 2); }
        if (IN(base + 3)) {
            constexpr int mixer_c = layer % 3;
            for (int rep = 0; rep < REPS(3); ++rep) {
            if constexpr (mixer_c == 0) { if (ATTN_MFMA_MASK & 1) att::attn_phase<0>(QKV, 3 * D, D, 2 * D, 1, Ob, kmean, nullptr, lds, wave0); }
            else if constexpr (mixer_c == 1) { if (ATTN_MFMA_MASK & 2) att::attn_phase<1>(QKV, 1536, D, D + 256, 4, Ob, nullptr, args.in[6] + (layer / 3) * NH, lds, wave0); }
            else { if (ATTN_MFMA_MASK & 4) att::attn_phase<2>(QKV, 3 * D, D, 2 * D, 1, Ob, nullptr, nullptr, lds, wave0); }
            }
            SEAM(base + 3);
        }
        if (IN(base + 4)) {
            pg8::DenseOrder S; S.init(Ob, (const bf16_t*)(ws + WS_WO), M, D, D, G, (int)blockIdx.x);
            pg8::EpiResF32 E{xres, T};
            for (int rep = 0; rep < REPS(4); ++rep) pg8::gemm_phase<pg8::EpiResF32, pg8::DenseOrder, true, false>(lds, D, S, E, wave0);
            SEAM(base + 4);
        }
        if (IN(base + 5)) {
            for (int rep = 0; rep < REPS(5); ++rep) { OPQ(); (void)tid; phase_ln1_route(T, args.in[9] + layer * D, args.in[10] + layer * D, X, xb_oth, (const bf16_t*)(ws + WS_WRF), args.in[14] + layer * 4,
                            args.in[16] + layer * 32, rep ? cnt + 16 : cnt, rep ? (int*)(ws + WS_END) : list, rep ? (TokInfo*)(ws + WS_END + 4 * MiB) : ti, lds, wave, lane, gw, NGW); }
            SEAM(base + 5);
        }
        if (IN(base + 6)) {
            { OPQ(); (void)lane; (void)gw; moe_tables(cnt, tbl, tid); }
            pg8::MoeOrder S; S.A = xb_oth; S.Bt = (const bf16_t*)(ws + WS_W1); S.K = D; S.strideB = (size_t)1024 * D; S.list = list; S.tbl = tbl; S.G = G; S.c = (int)blockIdx.x;
            pg8::EpiSwiglu E{Hb};
            for (int rep = 0; rep < REPS(6); ++rep) pg8::gemm_phase<pg8::EpiSwiglu, pg8::MoeOrder, true, true>(lds, D, S, E, wave0);
            SEAM(base + 6);
        }
        if (IN(base + 7)) {
            { OPQ(); (void)lane; (void)gw; moe_tables(cnt, tbl, tid); }
            pg8::MoeOrder2 S; S.A = Hb; S.Bt = (const bf16_t*)(ws + WS_W2); S.K = DE; S.strideB = (size_t)1024 * DE; S.list = list; S.tbl = tbl; S.G = G; S.c = (int)blockIdx.x;
            pg8::EpiStoreBf16 E{Yb, D, 1.f, 0};
            for (int rep = 0; rep < REPS(7); ++rep) pg8::gemm_phase<pg8::EpiStoreBf16, pg8::MoeOrder2, true, false>(lds, DE, S, E, wave0);
            SEAM(base + 7);
        }
        if (IN(base + 8)) {
            OPQ(); moe_tables(cnt, tbl, tid);
            phase_ln2(X, X, Yb, ti, tbl, args.in[11] + layer * D, args.in[12] + layer * D, xb_cur, gw, NGW, lane);
            if (REPS(8) > 1) phase_ln2(X, (float*)(ws + WS_END + 8 * MiB), Yb, ti, tbl, args.in[11] + layer * D, args.in[12] + layer * D, (bf16_t*)(ws + WS_END + 136 * MiB), gw, NGW, lane);
            SEAM(base + 8);
        }
        if (IN(base + 9)) {
            pg8::DenseOrder S; S.init(xb_cur, (const bf16_t*)(ws + WS_WPG), M, D, D, G, (int)blockIdx.x);
            pg8::EpiPle E{X, (layer == DEPTH - 1) ? args.out : X, PP, xb_oth};
            pg8::gemm_phase<pg8::EpiPle, pg8::DenseOrder, true, false>(lds, D, S, E, wave0);
            if (REPS(9) > 1) { pg8::EpiPle E2{X, (float*)(ws + WS_END + 8 * MiB), PP, (bf16_t*)(ws + WS_END + 136 * MiB)}; pg8::gemm_phase<pg8::EpiPle, pg8::DenseOrder, true, false>(lds, D, S, E2, wave0); }
            SEAM(base + 9);
        }
    }
#undef IN
#undef SEAM
#undef OPQ
}
__global__ void __launch_bounds__(NTHREADS, 2) mk_fwd(Args args) {
    extern __shared__ __attribute__((aligned(16))) unsigned char lds_raw[];
    LAS unsigned char* lds = (LAS unsigned char*)lds_raw;
    const int tid0 = threadIdx.x; const int wave0 = __builtin_amdgcn_readfirstlane(tid0 >> 6);
    volatile LAS unsigned* MISC = (volatile LAS unsigned*)(lds + MISC_OFF);
    for (int u = tid0; u < 256; u += NTHREADS) MISC[u] = 0u;
    __syncthreads();
    unsigned char* ws = args.ws;
    unsigned* ctl = (unsigned*)(ws + WS_CTL);
    XcdBarrier bar = xcd_barrier_post(ctl + CW_BAR + args.li * XCD_BAR_WORDS, MISC + MISC_BAR);
    KCtx kc; kc.lds = lds; kc.tbl = (LAS int*)(lds + MISC_OFF) + MISC_TBL; kc.ws = ws; kc.ctl = ctl; kc.lo = args.ph_lo; kc.hi = args.ph_hi; kc.G = gridDim.x; kc.NGW = gridDim.x * NWAVES; kc.wave0 = wave0;
    run_layer<0>(args, kc, bar); run_layer<1>(args, kc, bar); run_layer<2>(args, kc, bar); run_layer<3>(args, kc, bar);
}

extern "C" void kernel_launch(void* const* d_in, const int* in_sizes, int n_in, void* d_out, int out_size, void* d_ws, size_t ws_size, hipStream_t stream) {
    static int grid = 0;
    if (grid == 0) {
        if (n_in != 22 || ws_size < WS_END) { fprintf(stderr, "kernel_launch: unexpected inputs (n_in %d, ws %zu)\n", n_in, ws_size); grid = -1; return; }
        int dev = 0, cus = 0;
        if (hipGetDevice(&dev) != hipSuccess || hipDeviceGetAttribute(&cus, hipDeviceAttributeMultiprocessorCount, dev) != hipSuccess) { grid = -1; return; }
        if (hipFuncSetAttribute((const void*)mk_fwd, hipFuncAttributeMaxDynamicSharedMemorySize, LDS_BYTES) != hipSuccess) { fprintf(stderr, "kernel_launch: hipFuncSetAttribute failed\n"); grid = -1; return; }
        int per_cu = 0;
        if (hipOccupancyMaxActiveBlocksPerMultiprocessor(&per_cu, (const void*)mk_fwd, NTHREADS, LDS_BYTES) != hipSuccess || per_cu < 1) { fprintf(stderr, "kernel_launch: occupancy query says %d\n", per_cu); }
        (void)hipGetLastError();
        grid = cus;
    }
    if (grid < 0) return;
    (void)hipMemsetAsync((char*)d_ws + WS_CTL, 0, CTL_ZERO_BYTES, stream);
    Args a{};
    for (int i = 0; i < 22; ++i) a.in[i] = (const float*)d_in[i];
    a.out = (float*)d_out; a.ws = (unsigned char*)d_ws;
    unsigned char* ws = (unsigned char*)d_ws;
    int li = 0, seg_lo = 0;
    const float inv_c2 = 1.0f / (0.125f * LOG2E);
    for (int layer = 0; layer < DEPTH; ++layer) {
        const int mixer = layer % 3, j = layer / 3, base = layer * NPH;
        if ((ATTN_MFMA_MASK >> mixer) & 1) continue;
        a.ph_lo = seg_lo; a.ph_hi = base + 3; a.li = li++;
        hipLaunchKernelGGL(mk_fwd, dim3(grid), dim3(NTHREADS), LDS_BYTES, stream, a);
        const bf16_t* QKV = (const bf16_t*)(ws + WS_QKV); bf16_t* Ob = (bf16_t*)(ws + WS_O); const float* kmean = (const float*)(ws + WS_KMEAN);
        if (mixer == 0) hipLaunchKernelGGL(k_attn<0>, dim3(8, 16, 16), dim3(256), 0, stream, QKV, 3 * D, QKV + D, QKV + 2 * D, 3 * D, 1, Ob, kmean, (const float*)nullptr, inv_c2);
        else if (mixer == 1) hipLaunchKernelGGL(k_attn<1>, dim3(8, 16, 16), dim3(256), 0, stream, QKV, 1536, QKV + D, QKV + D + 256, 1536, 4, Ob, (const float*)nullptr, (const float*)d_in[6] + j * NH, inv_c2);
        else hipLaunchKernelGGL(k_attn<2>, dim3(8, 16, 16), dim3(256), 0, stream, QKV, 3 * D, QKV + D, QKV + 2 * D, 3 * D, 1, Ob, (const float*)nullptr, (const float*)nullptr, inv_c2);
        seg_lo = base + 4;
    }
    a.ph_lo = seg_lo; a.ph_hi = DEPTH * NPH; a.li = li++;
    hipLaunchKernelGGL(mk_fwd, dim3(grid), dim3(NTHREADS), LDS_BYTES, stream, a);
}
```
